# Optimizing an MI355X kernel written in HIP

```python
import math
import jax, jax.numpy as jnp
from jax import lax
import numpy as np

D_MODEL = 1024
BATCH = 4
SEQ = 4096
DEPTH = 1

EPS = 1e-6
ROPE_BASE = 10000.0
N_MLA_HEADS = 8
QK_NOPE = 64
QK_ROPE = 32
V_HEAD = 64
Q_LORA = 256
KV_LORA = 128
Q_BLOCK = 128
N_RET_HEADS = 4
RET_DK = 128
RET_DV = 128
RET_CHUNK = 128
MLA_WIDTH = N_MLA_HEADS * V_HEAD
RET_WIDTH = N_RET_HEADS * RET_DV
D_MIX = MLA_WIDTH + RET_WIDTH
IN_SPLITS = (Q_LORA, KV_LORA, QK_ROPE,
             N_RET_HEADS * RET_DK, N_RET_HEADS * RET_DK,
             N_RET_HEADS * RET_DV, N_RET_HEADS * RET_DV)
IN_COLS = sum(IN_SPLITS)
MEM_LEN = 256
N_XATTN_HEADS = 4
XATTN_HEAD = D_MODEL // N_XATTN_HEADS
D_FF = 2816
CONV_W = 3

kernel_name = "hymba_mla_retnet_convffn_layer"


def rmsnorm(x, g):
    x32 = x.astype(jnp.float32)
    inv = lax.rsqrt(jnp.mean(x32 * x32, axis=-1, keepdims=True) + EPS)
    return (x32 * inv * g.astype(jnp.float32)).astype(x.dtype)


def rope(x, positions):
    d = x.shape[-1]
    inv_freq = 1.0 / (ROPE_BASE ** (jnp.arange(0, d, 2, dtype=jnp.float32) / d))
    ang = positions.astype(jnp.float32)[..., None] * inv_freq
    ang = ang.reshape(ang.shape[:2] + (1,) * (x.ndim - 3) + (d // 2,))
    cos, sin = jnp.cos(ang), jnp.sin(ang)
    x32 = x.astype(jnp.float32)
    x1, x2 = x32[..., : d // 2], x32[..., d // 2:]
    out = jnp.concatenate([x1 * cos - x2 * sin, x2 * cos + x1 * sin], axis=-1)
    return out.astype(x.dtype)


def mla_group(c_q, c_kv, k_rope_raw, positions, g_q_lat, w_uq, g_kv_lat, w_ukv):
    B, S, _ = c_q.shape
    q = (rmsnorm(c_q, g_q_lat) @ w_uq).reshape(B, S, N_MLA_HEADS, QK_NOPE + QK_ROPE)
    q_nope, q_rope = q[..., :QK_NOPE], rope(q[..., QK_NOPE:], positions)
    kv = (rmsnorm(c_kv, g_kv_lat) @ w_ukv).reshape(B, S, N_MLA_HEADS, QK_NOPE + V_HEAD)
    k_nope, v = kv[..., :QK_NOPE], kv[..., QK_NOPE:]
    k_rope = rope(k_rope_raw, positions)
    scale = 1.0 / math.sqrt(QK_NOPE + QK_ROPE)

    nb = S // Q_BLOCK
    qn_blocks = q_nope.reshape(B, nb, Q_BLOCK, N_MLA_HEADS, QK_NOPE).transpose(1, 0, 2, 3, 4)
    qr_blocks = q_rope.reshape(B, nb, Q_BLOCK, N_MLA_HEADS, QK_ROPE).transpose(1, 0, 2, 3, 4)
    starts = jnp.arange(nb, dtype=jnp.int32) * Q_BLOCK
    key_idx = jnp.arange(S, dtype=jnp.int32)

    def one_block(args):
        qn_b, qr_b, start = args
        s = (jnp.einsum('bqhd,bkhd->bhqk', qn_b, k_nope)
             + jnp.einsum('bqhd,bkd->bhqk', qr_b, k_rope)).astype(jnp.float32) * scale
        q_idx = start + jnp.arange(Q_BLOCK, dtype=jnp.int32)
        mask = key_idx[None, :] <= q_idx[:, None]
        s = jnp.where(mask[None, None], s, jnp.finfo(jnp.float32).min)
        p = jax.nn.softmax(s, axis=-1).astype(v.dtype)
        return jnp.einsum('bhqk,bkhd->bqhd', p, v)

    out = lax.map(one_block, (qn_blocks, qr_blocks, starts))
    return out.transpose(1, 0, 2, 3, 4).reshape(B, S, MLA_WIDTH)


def retention_group(q, k, v, g, positions):
    B, S, _ = q.shape
    H, L = N_RET_HEADS, RET_CHUNK
    C = S // L
    q = rope(q.reshape(B, S, H, RET_DK), positions)
    k = rope(k.reshape(B, S, H, RET_DK), positions) * (RET_DK ** -0.5)
    v = v.reshape(B, S, H, RET_DV)
    dt = q.dtype

    log_gamma = jnp.log(1.0 - 2.0 ** (-5.0 - jnp.arange(H, dtype=jnp.float32)))
    j = jnp.arange(L, dtype=jnp.float32)
    diff = j[:, None] - j[None, :]
    intra = jnp.where(diff[None] >= 0,
                      jnp.exp(jnp.maximum(diff, 0.0)[None] * log_gamma[:, None, None]),
                      0.0).astype(dt)
    k_to_end = jnp.exp((L - 1 - j)[:, None] * log_gamma[None, :]).astype(dt)
    q_from_start = jnp.exp((j + 1)[:, None] * log_gamma[None, :]).astype(dt)
    chunk_decay = jnp.exp(L * log_gamma).astype(dt)

    qc = q.reshape(B, C, L, H, RET_DK)
    kc = k.reshape(B, C, L, H, RET_DK)
    vc = v.reshape(B, C, L, H, RET_DV)

    scores = jnp.einsum('bclhd,bcmhd->bchlm', qc, kc) * intra[None, None]
    inner = jnp.einsum('bchlm,bcmhe->bclhe', scores, vc)

    chunk_kv = jnp.einsum('bclhd,bclhe->cbhde', kc * k_to_end[None, None, :, :, None], vc)

    def step(state, kv_c):
        return chunk_decay[None, :, None, None] * state + kv_c, state

    init = jnp.zeros((B, H, RET_DK, RET_DV), dtype=chunk_kv.dtype)
    _, prev_states = lax.scan(step, init, chunk_kv)
    cross = jnp.einsum('bclhd,cbhde->bclhe',
                       qc * q_from_start[None, None, :, :, None], prev_states)
    out = (inner + cross).reshape(B, S, H, RET_DV)

    o32 = out.astype(jnp.float32)
    mu = jnp.mean(o32, axis=-1, keepdims=True)
    var = jnp.mean(jnp.square(o32 - mu), axis=-1, keepdims=True)
    o = ((o32 - mu) * lax.rsqrt(var + EPS)).astype(dt).reshape(B, S, RET_WIDTH)
    return o * jax.nn.silu(g)


def memory_cross_attention(h, mem_n, w_xq, w_xkv, w_xo):
    B, S, _ = h.shape
    M = mem_n.shape[1]
    q = (h @ w_xq).reshape(B, S, N_XATTN_HEADS, XATTN_HEAD)
    kv = (mem_n @ w_xkv).reshape(B, M, 2, N_XATTN_HEADS, XATTN_HEAD)
    k, v = kv[:, :, 0], kv[:, :, 1]
    s = jnp.einsum('bqhd,bkhd->bhqk', q, k).astype(jnp.float32) / math.sqrt(XATTN_HEAD)
    p = jax.nn.softmax(s, axis=-1).astype(v.dtype)
    o = jnp.einsum('bhqk,bkhd->bqhd', p, v).reshape(B, S, N_XATTN_HEADS * XATTN_HEAD)
    return o @ w_xo


def conv_gated_mlp(h, w_ffn_in, conv_w, conv_b, w_ffn_out):
    gu = h @ w_ffn_in
    gate, up = gu[..., :D_FF], gu[..., D_FF:]
    gp = jnp.pad(gate, ((0, 0), (CONV_W - 1, 0), (0, 0)))
    S = gate.shape[1]
    conv = conv_b + sum(gp[:, i:i + S] * conv_w[i] for i in range(CONV_W))
    return (jax.nn.silu(conv) * up) @ w_ffn_out


def setup_inputs(seed: int = 0) -> dict:
    key = jax.random.key(seed)
    ks = jax.random.split(key, 24)

    def nrm(k, shape, fan_in):
        return jax.random.normal(k, shape, jnp.float32) * (fan_in ** -0.5)

    def gain(k, shape):
        return 1.0 + 0.01 * jax.random.normal(k, shape, jnp.float32)

    x = jax.random.normal(ks[0], (BATCH, SEQ, D_MODEL), jnp.float32)
    mem = jax.random.normal(ks[1], (BATCH, MEM_LEN, D_MODEL), jnp.float32)
    offset = jax.random.randint(ks[2], (BATCH, 1), 0, 1024, dtype=jnp.int32)
    positions = offset + jnp.arange(SEQ, dtype=jnp.int32)[None, :]
    return {
        "x": x,
        "mem": mem,
        "positions": positions,
        "g_mix": gain(ks[3], (DEPTH, D_MODEL)),
        "w_in": nrm(ks[4], (DEPTH, D_MODEL, IN_COLS), D_MODEL),
        "g_q_lat": gain(ks[5], (DEPTH, Q_LORA)),
        "w_uq": nrm(ks[6], (DEPTH, Q_LORA, N_MLA_HEADS * (QK_NOPE + QK_ROPE)), Q_LORA),
        "g_kv_lat": gain(ks[7], (DEPTH, KV_LORA)),
        "w_ukv": nrm(ks[8], (DEPTH, KV_LORA, N_MLA_HEADS * (QK_NOPE + V_HEAD)), KV_LORA),
        "w_out": nrm(ks[9], (DEPTH, D_MIX, D_MODEL), D_MIX),
        "g_xattn": gain(ks[10], (DEPTH, D_MODEL)),
        "g_mem": gain(ks[11], (DEPTH, D_MODEL)),
        "w_xq": nrm(ks[12], (DEPTH, D_MODEL, N_XATTN_HEADS * XATTN_HEAD), D_MODEL),
        "w_xkv": nrm(ks[13], (DEPTH, D_MODEL, 2 * N_XATTN_HEADS * XATTN_HEAD), D_MODEL),
        "w_xo": nrm(ks[14], (DEPTH, N_XATTN_HEADS * XATTN_HEAD, D_MODEL), N_XATTN_HEADS * XATTN_HEAD),
        "g_ffn": gain(ks[15], (DEPTH, D_MODEL)),
        "w_ffn_in": nrm(ks[16], (DEPTH, D_MODEL, 2 * D_FF), D_MODEL),
        "conv_w": nrm(ks[17], (DEPTH, CONV_W, D_FF), CONV_W),
        "conv_b": 0.01 * jax.random.normal(ks[18], (DEPTH, D_FF), jnp.float32),
        "w_ffn_out": nrm(ks[19], (DEPTH, D_FF, D_MODEL), D_FF),
        "g_final": gain(ks[20], (D_MODEL,)),
    }


def reference(x, mem, positions, g_mix, w_in, g_q_lat, w_uq, g_kv_lat, w_ukv, w_out,
              g_xattn, g_mem, w_xq, w_xkv, w_xo, g_ffn, w_ffn_in, conv_w, conv_b,
              w_ffn_out, g_final):
    offs = np.cumsum((0,) + IN_SPLITS)
    for l in range(DEPTH):
        h = rmsnorm(x, g_mix[l])
        proj = h @ w_in[l]
        c_q, c_kv, k_rope_raw, rq, rk, rv, rg = [proj[..., offs[i]:offs[i + 1]]
                                                 for i in range(len(IN_SPLITS))]
        y_mla = mla_group(c_q, c_kv, k_rope_raw, positions,
                          g_q_lat[l], w_uq[l], g_kv_lat[l], w_ukv[l])
        y_ret = retention_group(rq, rk, rv, rg, positions)
        x = x + jnp.concatenate([y_mla, y_ret], axis=-1) @ w_out[l]
        x = x + memory_cross_attention(rmsnorm(x, g_xattn[l]), rmsnorm(mem, g_mem[l]),
                                       w_xq[l], w_xkv[l], w_xo[l])
        x = x + conv_gated_mlp(rmsnorm(x, g_ffn[l]), w_ffn_in[l], conv_w[l], conv_b[l],
                               w_ffn_out[l])
    return rmsnorm(x, g_final)
```

```cpp
#include <hip/hip_runtime.h>
#include <cstdio>
#include <cstdint>
#include <cmath>

#ifndef MK_N_LAUNCHES
#define MK_N_LAUNCHES 1
#endif

typedef unsigned short bf16;
typedef short bf16x8 __attribute__((ext_vector_type(8)));
typedef short s16x4 __attribute__((ext_vector_type(4)));
typedef float f32x4 __attribute__((ext_vector_type(4)));
typedef float f32x2 __attribute__((ext_vector_type(2)));
typedef float f32x16 __attribute__((ext_vector_type(16)));
typedef unsigned u32x4 __attribute__((ext_vector_type(4)));
typedef unsigned u32x2 __attribute__((ext_vector_type(2)));
#define LAS __attribute__((address_space(3)))
#define GAS __attribute__((address_space(1)))
typedef GAS unsigned gu32;

constexpr int NB = 4, SEQ = 4096, D = 1024, M = NB * SEQ;
constexpr int NPROJ = 2560;
constexpr int NLAT = 384;
constexpr int NUP = 1792;
constexpr int DFF = 2816, NFF = 2 * DFF;
constexpr float EPS = 1e-6f;
constexpr float LOG2E = 1.4426950408889634f;
constexpr float C2_MLA = 0.10206207261596575f * LOG2E;
constexpr float C2_X = 0.0625f * LOG2E;
constexpr float RET_KSCALE = 0.08838834764831845f;
constexpr int FF_BLK = 62, FF_TROWS = 4 * FF_BLK, FF_NM = (M + FF_TROWS - 1) / FF_TROWS;

constexpr size_t MiB = 1u << 20;
constexpr size_t WS_CTL = 0, CTL_ZERO_BYTES = 1 * MiB;
constexpr size_t WS_WIN = 1 * MiB;
constexpr size_t WS_WUP = 6 * MiB;
constexpr size_t WS_WOUT = 8 * MiB, WS_WXQ = 10 * MiB, WS_WXKV = 12 * MiB, WS_WXO = 16 * MiB;
constexpr size_t WS_WFFI = 18 * MiB;
constexpr size_t WS_WFFO = 29 * MiB;
constexpr size_t WS_CS = 35 * MiB;
constexpr size_t WS_SSQL = 43 * MiB;
constexpr size_t WS_SSQ1 = 44 * MiB, WS_SSQ2 = 45 * MiB;
constexpr size_t WS_MEMN = 46 * MiB, WS_MKV = 48 * MiB;
constexpr size_t WS_A = 52 * MiB;
constexpr size_t WS_B = 84 * MiB;
constexpr size_t WS_LAT = WS_B, WS_KR = WS_B + 12 * MiB, WS_RQ = WS_B + 13 * MiB, WS_RK = WS_B + 29 * MiB, WS_RV = WS_B + 45 * MiB, WS_RG = WS_B + 61 * MiB;
constexpr size_t WS_C = 161 * MiB;
constexpr size_t WS_KVT = 217 * MiB;
constexpr size_t WS_XB1 = WS_B, WS_H = WS_B, WS_QX = 172 * MiB, WS_OX = 204 * MiB;
constexpr size_t WS_END = 256 * MiB;
static_assert(WS_KVT + 32 * MiB <= WS_END && WS_OX + 32 * MiB <= WS_END && WS_H + (size_t)M * DFF * 2 <= WS_QX, "d_ws map");
constexpr int CW_TMO = 0, CW_BAR = 4096;

constexpr int RING_BYTES = 131072, LDSCTL_OFF = RING_BYTES, MISC_OFF = LDSCTL_OFF + 320, LDS_BYTES = 147456;

#define RLX_AGENT __ATOMIC_RELAXED, __HIP_MEMORY_SCOPE_AGENT
__device__ __forceinline__ unsigned cvt_pk(float lo, float hi) { unsigned r; asm volatile("v_cvt_pk_bf16_f32 %0, %1, %2" : "=v"(r) : "v"(lo), "v"(hi)); return r; }
__device__ __forceinline__ float bf2f(unsigned short b) { return __uint_as_float((unsigned)b << 16); }
__device__ __forceinline__ float wave_sum(float v) {
#pragma unroll
    for (int o = 1; o < 64; o <<= 1) v += __shfl_xor(v, o);
    return v;
}
__device__ __forceinline__ float silu_f(float x) { return x * __builtin_amdgcn_rcpf(1.0f + __builtin_amdgcn_exp2f(-x * LOG2E)); }
__device__ __forceinline__ int crow(int r, int hi) { return (r & 3) + 8 * (r >> 2) + 4 * hi; }
__device__ __forceinline__ bf16x8 pack8(float a0, float a1, float a2, float a3, float a4, float a5, float a6, float a7) {
    u32x4 w; w.x = cvt_pk(a0, a1); w.y = cvt_pk(a2, a3); w.z = cvt_pk(a4, a5); w.w = cvt_pk(a6, a7); return __builtin_bit_cast(bf16x8, w);
}
typedef short v4i16_t __attribute__((ext_vector_type(4)));
__device__ __forceinline__ s16x4 tr_read(const LAS unsigned char* p) { return __builtin_bit_cast(s16x4, __builtin_amdgcn_ds_read_tr16_b64_v4i16((LAS v4i16_t*)p)); }
__device__ __forceinline__ bf16x8 tr_frag(const LAS unsigned char* p0, const LAS unsigned char* p1) {
    const s16x4 lo = tr_read(p0), hi = tr_read(p1);
    return (bf16x8){lo[0], lo[1], lo[2], lo[3], hi[0], hi[1], hi[2], hi[3]};
}
template <class T> __device__ __forceinline__ T* at(T* base, unsigned byte_off) { return (T*)((char*)base + byte_off); }
template <class T> __device__ __forceinline__ const T* at(const T* base, unsigned byte_off) { return (const T*)((const char*)base + byte_off); }
#define MFMA32(a, b, c) __builtin_amdgcn_mfma_f32_32x32x16_bf16((a), (b), (c), 0, 0, 0)

namespace pg8 {
constexpr int BM = 256, BK = 64, HALF = 128, HTB = HALF * BK * 2, STAGE_BYTES = 8 * HTB, NXCD = 8, WGM = 8;
__host__ __device__ __forceinline__ int lds_byte(int r, int c) { const int st = (r >> 4) * 2 + (c >> 5), rr = r & 15, cc = c & 31, ob = rr * 64 + cc * 2; return st * 1024 + (ob ^ (((ob >> 9) & 1) << 5)); }
__host__ __device__ __forceinline__ void stage_rc(int b, int& R, int& C) { const int st = b / 1024, sb = b % 1024, swz = sb ^ (((sb >> 9) & 1) << 5); R = (st >> 1) * 16 + swz / 64; C = (st & 1) * 32 + (swz % 64) / 2; }
__host__ __device__ __forceinline__ int perm32(int rho) { const int n = rho >> 4, i = rho & 15; return 8 * (i >> 2) + 4 * n + (i & 3); }

struct Unit { int pm, pn; };
struct Gemm { const bf16* A; const bf16* Bt; int K; int a_blk; };

struct StaticOrder {
    int nM, nN, nwg, G, c;
    __device__ void init(int nM_, int nN_, int G_, int c_) { nM = nM_; nN = nN_; nwg = nM * nN; G = G_; c = c_; }
    __device__ bool next(int i, Unit& u) const {
        const long L = (long)i * G + c; if (L >= nwg) return false;
        int wgid = (int)L; { const int q = nwg / NXCD, r = nwg % NXCD, xcd = wgid % NXCD, off = wgid / NXCD; wgid = (xcd < r ? xcd * (q + 1) : r * (q + 1) + (xcd - r) * q) + off; }
        const int nig = WGM * nN, gid = wgid / nig, fm = gid * WGM, gsz = (nM - fm) < WGM ? (nM - fm) : WGM;
        u.pm = fm + ((wgid % nig) % gsz); u.pn = (wgid % nig) / gsz; return true;
    }
};

template <class Epi>
__device__ __forceinline__ void gemm_phase(LAS unsigned char* lds, const Gemm g, const StaticOrder& S, const Epi& E) {
    int tid = threadIdx.x; asm volatile("" : "+v"(tid));
    const int wid = __builtin_amdgcn_readfirstlane(tid >> 6), lane = tid & 63, wr = wid >> 2, wc = wid & 3, fr = lane & 15, fq = lane >> 4;
    const int K = g.K, nt = K / BK;
    unsigned voffA[2], voffB[2];
#pragma unroll
    for (int i = 0; i < 2; ++i) { int R, C; stage_rc(tid * 16 + i * 8192, R, C); const int Rb = (R & ~31) + perm32(R & 31); const int Ra = (R >> 6) * g.a_blk + (R & 63);
        voffA[i] = (unsigned)(Ra * K + C) * 2u; voffB[i] = (unsigned)(Rb * K + C) * 2u; }
    const size_t kstep = (size_t)(BK * 2);
    const size_t hstepA = (size_t)2 * g.a_blk * K * 2, tstepA = 2 * hstepA;
    const size_t hstepB = (size_t)HALF * K * 2, tstepB = 2 * hstepB;
    const unsigned ldsw = (unsigned)wid * 1024u;
    const int aoff = lds_byte(wr * 64 + fr, fq * 8), boff = lds_byte(wc * 32 + fr, fq * 8);
#define PG8_SA(b, h) (((b) * 2 + (h)) * HTB)
#define PG8_SB(b, h) ((4 + (b) * 2 + (h)) * HTB)
#define PG8_STAGE(bufoff, gbase, voff) do { _Pragma("unroll") for (int _i = 0; _i < 2; ++_i) \
        __builtin_amdgcn_global_load_lds((const unsigned*)((const char*)(gbase) + (voff)[_i]), (LAS unsigned*)(lds + (bufoff) + ldsw + _i * 8192), 16, 0, 0); } while (0)
#define PG8_LDA(dst, b, h) do { _Pragma("unroll") for (int m = 0; m < 4; ++m) _Pragma("unroll") for (int k = 0; k < 2; ++k) dst[m][k] = *(const LAS bf16x8*)(lds + PG8_SA(b, h) + aoff + m * 2048 + k * 1024); } while (0)
#define PG8_LDB(dst, b, h) do { _Pragma("unroll") for (int n = 0; n < 2; ++n) _Pragma("unroll") for (int k = 0; k < 2; ++k) dst[n][k] = *(const LAS bf16x8*)(lds + PG8_SB(b, h) + boff + n * 2048 + k * 1024); } while (0)
#define PG8_MMA(ai, bj, At, Bt) do { __builtin_amdgcn_s_setprio(1); _Pragma("unroll") for (int m = 0; m < 4; ++m) _Pragma("unroll") for (int n = 0; n < 2; ++n) _Pragma("unroll") for (int k = 0; k < 2; ++k) \
        acc[ai][bj][m][n] = __builtin_amdgcn_mfma_f32_16x16x32_bf16(Bt[n][k], At[m][k], acc[ai][bj][m][n], 0, 0, 0); __builtin_amdgcn_s_setprio(0); } while (0)
#define PG8_WAIT_V(n) asm volatile("s_waitcnt vmcnt(" #n ")" ::: "memory")
#define PG8_WAIT_L(n) asm volatile("s_waitcnt lgkmcnt(" #n ")" ::: "memory")
#define PG8_BAR __builtin_amdgcn_s_barrier()
#define PG8_SCHED __builtin_amdgcn_sched_barrier(0)
    Unit cur, nxt; int ui = 0;
    if (!S.next(0, cur)) return;
    f32x4 acc[2][2][4][2];
#pragma unroll
    for (int a = 0; a < 2; ++a)
#pragma unroll
        for (int b = 0; b < 2; ++b)
#pragma unroll
            for (int m = 0; m < 4; ++m)
#pragma unroll
                for (int n = 0; n < 2; ++n) acc[a][b][m][n] = (f32x4){0.f, 0.f, 0.f, 0.f};
    bf16x8 At[4][2], B0[2][2], B1[2][2];
    const char* cA = (const char*)g.A + (size_t)cur.pm * tstepA; const char* cB = (const char*)g.Bt + (size_t)cur.pn * tstepB;
    PG8_STAGE(PG8_SB(0, 0), cB, voffB); PG8_STAGE(PG8_SB(0, 1), cB + hstepB, voffB); PG8_STAGE(PG8_SA(0, 0), cA, voffA); PG8_STAGE(PG8_SA(0, 1), cA + hstepA, voffA);
    if (wr == 1) PG8_BAR;
    PG8_WAIT_V(2); PG8_BAR;
    PG8_STAGE(PG8_SB(1, 0), cB + kstep, voffB); PG8_STAGE(PG8_SA(1, 0), cA + kstep, voffA); PG8_STAGE(PG8_SB(1, 1), cB + hstepB + kstep, voffB);
    PG8_WAIT_V(6); PG8_BAR;
    for (;;) {
        const bool has_next = S.next(ui + 1, nxt);
        const char* nA = has_next ? (const char*)g.A + (size_t)nxt.pm * tstepA : cA; const char* nB = has_next ? (const char*)g.Bt + (size_t)nxt.pn * tstepB : cB;
#pragma unroll 1
        for (int t = 0; t < nt; t += 2) {
            const bool last = (t == nt - 2);
            const char* a1 = cA + (size_t)(t + 1) * kstep;
            const char* a2 = last ? nA : cA + (size_t)(t + 2) * kstep; const char* b2 = last ? nB : cB + (size_t)(t + 2) * kstep;
            const char* a3 = a2 + kstep; const char* b3 = b2 + kstep;
            PG8_LDB(B0, 0, 0); PG8_LDB(B1, 0, 1); PG8_SCHED; PG8_LDA(At, 0, 0); PG8_STAGE(PG8_SA(1, 1), a1 + hstepA, voffA);
            PG8_WAIT_V(8); PG8_WAIT_L(0); PG8_BAR; PG8_MMA(0, 0, At, B0); PG8_MMA(0, 1, At, B1); PG8_BAR; PG8_SCHED;
            PG8_LDA(At, 0, 1); PG8_STAGE(PG8_SB(0, 0), b2, voffB); PG8_STAGE(PG8_SB(0, 1), b2 + hstepB, voffB); PG8_STAGE(PG8_SA(0, 0), a2, voffA);
            PG8_WAIT_V(8); PG8_WAIT_L(0); PG8_BAR; PG8_MMA(1, 0, At, B0); PG8_MMA(1, 1, At, B1); PG8_BAR; PG8_SCHED;
            PG8_LDB(B0, 1, 0); PG8_LDB(B1, 1, 1); PG8_SCHED; PG8_LDA(At, 1, 0); PG8_STAGE(PG8_SA(0, 1), a2 + hstepA, voffA);
            PG8_WAIT_V(8); PG8_WAIT_L(0); PG8_BAR; PG8_MMA(0, 0, At, B0); PG8_MMA(0, 1, At, B1); PG8_BAR; PG8_SCHED;
            PG8_LDA(At, 1, 1); PG8_STAGE(PG8_SB(1, 0), b3, voffB); PG8_STAGE(PG8_SB(1, 1), b3 + hstepB, voffB); PG8_STAGE(PG8_SA(1, 0), a3, voffA);
            PG8_WAIT_V(8); PG8_WAIT_L(0); PG8_BAR; PG8_MMA(1, 0, At, B0); PG8_MMA(1, 1, At, B1); PG8_BAR; PG8_SCHED;
        }
        if (wr == 0) PG8_BAR;
        E(acc, cur, wr, wc, fr, fq);
        if (!has_next) break;
#pragma unroll
        for (int a = 0; a < 2; ++a)
#pragma unroll
            for (int b = 0; b < 2; ++b)
#pragma unroll
                for (int m = 0; m < 4; ++m)
#pragma unroll
                    for (int n = 0; n < 2; ++n) acc[a][b][m][n] = (f32x4){0.f, 0.f, 0.f, 0.f};
        cur = nxt; cA = nA; cB = nB; ++ui;
        if (wr == 1) PG8_BAR;
    }
    PG8_WAIT_V(0);
    PG8_BAR;
#undef PG8_SA
#undef PG8_SB
#undef PG8_STAGE
#undef PG8_LDA
#undef PG8_LDB
#undef PG8_MMA
#undef PG8_WAIT_V
#undef PG8_WAIT_L
#undef PG8_BAR
#undef PG8_SCHED
}
}

typedef f32x4 Acc[2][2][4][2];
__device__ __forceinline__ void st8bf(bf16* p, const f32x4 a, const f32x4 b) { u32x4 w; w.x = cvt_pk(a[0], a[1]); w.y = cvt_pk(a[2], a[3]); w.z = cvt_pk(b[0], b[1]); w.w = cvt_pk(b[2], b[3]); *(u32x4*)p = w; }
__device__ __forceinline__ float ssq8(const f32x4 a, const f32x4 b) { return (a[0] * a[0] + a[1] * a[1]) + (a[2] * a[2] + a[3] * a[3]) + (b[0] * b[0] + b[1] * b[1]) + (b[2] * b[2] + b[3] * b[3]); }
__device__ __forceinline__ float red_fq(float s) { s += __shfl_xor(s, 16); s += __shfl_xor(s, 32); return s; }
__device__ __forceinline__ f32x4 rot2(const f32x4 v, const f32x4 cs) { return (f32x4){v[0] * cs[0] - v[1] * cs[1], v[1] * cs[0] + v[0] * cs[1], v[2] * cs[2] - v[3] * cs[3], v[3] * cs[2] + v[2] * cs[3]}; }

struct EpiProj {
    bf16 *LAT, *KR, *RQ, *RK, *RV, *RG; float* SSQL; const float* CS;
    __device__ __forceinline__ void operator()(const Acc& acc, const pg8::Unit& u, int wr, int wc, int fr, int fq) const {
        const int pn = u.pn;
#pragma unroll
        for (int ai = 0; ai < 2; ++ai)
#pragma unroll
            for (int m = 0; m < 4; ++m) {
                const int row = u.pm * 256 + ai * 128 + wr * 64 + m * 16 + fr;
                const int cw = 32 * wc + 8 * fq;
                if (pn == 0) {
                    float s = 0.f;
#pragma unroll
                    for (int bj = 0; bj < 2; ++bj) { st8bf(at(LAT, (unsigned)(row * NLAT + bj * 128 + cw) * 2u), acc[ai][bj][m][0], acc[ai][bj][m][1]); s += ssq8(acc[ai][bj][m][0], acc[ai][bj][m][1]); }
                    s = red_fq(s); if (fq == 0) *at(SSQL, (unsigned)(row * 8 + wc) * 4u) = s;
                } else if (pn == 1) {
                    st8bf(at(LAT, (unsigned)(row * NLAT + 256 + cw) * 2u), acc[ai][0][m][0], acc[ai][0][m][1]);
                    float s = red_fq(ssq8(acc[ai][0][m][0], acc[ai][0][m][1])); if (fq == 0) *at(SSQL, (unsigned)(row * 8 + 4 + wc) * 4u) = s;
                    if (wc == 0) {
                        const float* cs = at(CS, (unsigned)row * 512u);
                        f32x4 o[2];
#pragma unroll
                        for (int n = 0; n < 2; ++n) { const int i0 = 4 * fq + 2 * n; const f32x2 a = *(const f32x2*)(cs + 8 * i0), b = *(const f32x2*)(cs + 8 * i0 + 8);
                            o[n] = rot2(acc[ai][1][m][n], (f32x4){a[0], a[1], b[0], b[1]}); }
                        st8bf(at(KR, (unsigned)(row * 32 + 8 * fq) * 2u), o[0], o[1]);
                    }
                } else if (pn < 6) {
                    const float* cs = at(CS, (unsigned)row * 512u);
#pragma unroll
                    for (int bj = 0; bj < 2; ++bj) { const int head = 2 * (pn & 1) + bj; f32x4 o[2];
#pragma unroll
                        for (int n = 0; n < 2; ++n) { const int i0 = (cw + 4 * n) >> 1; o[n] = rot2(acc[ai][bj][m][n], *(const f32x4*)(cs + 2 * i0)); }
                        if (pn < 4) st8bf(at(RQ, (unsigned)(row * 512 + head * 128 + cw) * 2u), o[0], o[1]);
                        else { const float lg = __builtin_amdgcn_logf(1.0f - __builtin_amdgcn_exp2f(-5.0f - (float)head));
                            const float w = RET_KSCALE * __builtin_amdgcn_exp2f((float)(127 - (row & 127)) * lg);
                            st8bf(at(RK, (unsigned)(row * 512 + head * 128 + cw) * 2u), o[0] * w, o[1] * w); } }
                } else if (pn < 8) {
#pragma unroll
                    for (int bj = 0; bj < 2; ++bj) st8bf(at(RV, (unsigned)(row * 512 + (pn & 1) * 256 + bj * 128 + cw) * 2u), acc[ai][bj][m][0], acc[ai][bj][m][1]);
                } else {
#pragma unroll
                    for (int bj = 0; bj < 2; ++bj) { f32x4 a = acc[ai][bj][m][0], b = acc[ai][bj][m][1];
#pragma unroll
                        for (int e = 0; e < 4; ++e) { a[e] = silu_f(a[e]); b[e] = silu_f(b[e]); }
                        st8bf(at(RG, (unsigned)(row * 512 + (pn & 1) * 256 + bj * 128 + cw) * 2u), a, b); }
                }
            }
    }
};

struct EpiUp {
    bf16* QKV; const float* SSQL; const float* CS;
    __device__ __forceinline__ void operator()(const Acc& acc, const pg8::Unit& u, int wr, int wc, int fr, int fq) const {
        const bool isq = u.pn < 3;
#pragma unroll
        for (int ai = 0; ai < 2; ++ai)
#pragma unroll
            for (int m = 0; m < 4; ++m) {
                const int row = u.pm * 256 + ai * 128 + wr * 64 + m * 16 + fr;
                const f32x4 sq = *(const f32x4*)at(SSQL, (unsigned)(row * 8 + (isq ? 0 : 4)) * 4u);
                const float inv = 1.0f / sqrtf(((sq[0] + sq[1]) + (sq[2] + sq[3])) * (isq ? 1.0f / 256.0f : 1.0f / 128.0f) + EPS);
                const float sc = isq ? inv * C2_MLA : inv;
                const float* cs = at(CS, (unsigned)row * 512u);
#pragma unroll
                for (int bj = 0; bj < 2; ++bj) { const int col = u.pn * 256 + bj * 128 + 32 * wc + 8 * fq; f32x4 o[2];
#pragma unroll
                    for (int n = 0; n < 2; ++n) { o[n] = acc[ai][bj][m][n] * sc; const int hc = (col + 4 * n) % 96;
                        if (isq && hc >= 64) { const int i0 = (hc - 64) >> 1; const f32x2 a = *(const f32x2*)(cs + 8 * i0), b = *(const f32x2*)(cs + 8 * i0 + 8); o[n] = rot2(o[n], (f32x4){a[0], a[1], b[0], b[1]}); } }
                    st8bf(at(QKV, (unsigned)(row * NUP + col) * 2u), o[0], o[1]); }
                asm volatile("" ::: "memory");
            }
    }
};

struct EpiStore {
    bf16* O; int ldc; const float* SSQ16; float scale;
    __device__ __forceinline__ void operator()(const Acc& acc, const pg8::Unit& u, int wr, int wc, int fr, int fq) const {
#pragma unroll
        for (int ai = 0; ai < 2; ++ai)
#pragma unroll
            for (int m = 0; m < 4; ++m) {
                const int row = u.pm * 256 + ai * 128 + wr * 64 + m * 16 + fr;
                float sc = scale;
                if (SSQ16) { const f32x4* p = (const f32x4*)at(SSQ16, (unsigned)row * 64u); const f32x4 a = p[0], b = p[1], c = p[2], d = p[3];
                    const float t = ((a[0] + a[1]) + (a[2] + a[3])) + ((b[0] + b[1]) + (b[2] + b[3])) + ((c[0] + c[1]) + (c[2] + c[3])) + ((d[0] + d[1]) + (d[2] + d[3]));
                    sc *= 1.0f / sqrtf(t * (1.0f / 1024.0f) + EPS); }
#pragma unroll
                for (int bj = 0; bj < 2; ++bj) st8bf(at(O, (unsigned)(row * ldc + u.pn * 256 + bj * 128 + 32 * wc + 8 * fq) * 2u), acc[ai][bj][m][0] * sc, acc[ai][bj][m][1] * sc);
            }
    }
};

struct EpiRes {
    const float* base; float* out; bf16* XB; float* SSQ16;
    __device__ __forceinline__ void operator()(const Acc& acc, const pg8::Unit& u, int wr, int wc, int fr, int fq) const {
#pragma unroll
        for (int ai = 0; ai < 2; ++ai)
#pragma unroll
            for (int m = 0; m < 4; ++m) {
                const int row = u.pm * 256 + ai * 128 + wr * 64 + m * 16 + fr; float s = 0.f;
#pragma unroll
                for (int bj = 0; bj < 2; ++bj) { const unsigned off = (unsigned)(row * D + u.pn * 256 + bj * 128 + 32 * wc + 8 * fq);
                    const f32x4 a = *(const f32x4*)at(base, off * 4u) + acc[ai][bj][m][0], b = *(const f32x4*)at(base, off * 4u + 16u) + acc[ai][bj][m][1];
                    *(f32x4*)at(out, off * 4u) = a; *(f32x4*)at(out, off * 4u + 16u) = b;
                    if (XB) st8bf(at(XB, off * 2u), a, b);
                    s += ssq8(a, b); }
                if (SSQ16) { s = red_fq(s); if (fq == 0) *at(SSQ16, (unsigned)(row * 16 + u.pn * 4 + wc) * 4u) = s; }
                if (m & 1) asm volatile("" ::: "memory");
            }
    }
};

struct EpiFfn {
    bf16* H; const float* SSQ16; const float* cw; const float* cb;
    __device__ __forceinline__ void operator()(const Acc& acc, const pg8::Unit& u, int wr, int wc, int fr, int fq) const {
        const int lane = threadIdx.x & 63;
        const int colh = u.pn * 128 + 32 * wc + 8 * fq;
        f32x4 w0[2], w1[2], w2[2], bb[2];
#pragma unroll
        for (int n = 0; n < 2; ++n) { w0[n] = *(const f32x4*)(cw + colh + 4 * n); w1[n] = *(const f32x4*)(cw + DFF + colh + 4 * n); w2[n] = *(const f32x4*)(cw + 2 * DFF + colh + 4 * n); bb[n] = *(const f32x4*)(cb + colh + 4 * n); }
        const int src1 = (lane & 48) | ((fr + 15) & 15), src2 = (lane & 48) | ((fr + 14) & 15);
#pragma unroll
        for (int ai = 0; ai < 2; ++ai) {
            const int row0 = u.pm * FF_TROWS + (2 * ai + wr) * FF_BLK - 2;
            f32x4 gp[2] = {(f32x4){0.f, 0.f, 0.f, 0.f}, (f32x4){0.f, 0.f, 0.f, 0.f}};
#pragma unroll
            for (int m = 0; m < 4; ++m) {
                const int t = row0 + m * 16 + fr;
                const int tc = t < 0 ? 0 : (t >= M ? M - 1 : t);
                const f32x4* p = (const f32x4*)at(SSQ16, (unsigned)tc * 64u); const f32x4 a = p[0], b = p[1], c = p[2], d = p[3];
                const float tt = ((a[0] + a[1]) + (a[2] + a[3])) + ((b[0] + b[1]) + (b[2] + b[3])) + ((c[0] + c[1]) + (c[2] + c[3])) + ((d[0] + d[1]) + (d[2] + d[3]));
                const float inv = 1.0f / sqrtf(tt * (1.0f / 1024.0f) + EPS);
                const int ts = t & (SEQ - 1);
                f32x4 o[2], gc[2];
#pragma unroll
                for (int n = 0; n < 2; ++n) {
                    gc[n] = acc[ai][0][m][n] * inv;
#pragma unroll
                    for (int e = 0; e < 4; ++e) {
                        const float cur = gc[n][e], prv = gp[n][e];
                        float g1 = __shfl(fr == 15 ? prv : cur, src1), g0 = __shfl(fr >= 14 ? prv : cur, src2);
                        if (ts < 1) g1 = 0.f; if (ts < 2) g0 = 0.f;
                        const float cv = bb[n][e] + w0[n][e] * g0 + w1[n][e] * g1 + w2[n][e] * cur;
                        o[n][e] = silu_f(cv) * (acc[ai][1][m][n][e] * inv);
                    }
                    gp[n] = gc[n];
                }
                if ((m > 0 || fr >= 2) && t < M) st8bf(at(H, (unsigned)(t * DFF + colh) * 2u), o[0], o[1]);
                asm volatile("" ::: "memory");
            }
        }
    }
};

#define XB_TMO      128
#define XB_XCNT(j)  (256  + 64 * (j))
#define XB_XSUB(j)  (1280 + 64 * (j))
#define XB_XGEN(j)  (2304 + 64 * (j))
#define XB_TOP      3328
#define XB_TOPGEN   3392
#define XCD_BAR_WORDS 3456
#define XB_SPIN_CAP (1u << 18)
__device__ __forceinline__ unsigned xb_ld(unsigned* p)              { return __hip_atomic_load(p, __ATOMIC_RELAXED, __HIP_MEMORY_SCOPE_AGENT); }
__device__ __forceinline__ unsigned xb_add(unsigned* p, unsigned v) { return __hip_atomic_fetch_add(p, v, __ATOMIC_RELAXED, __HIP_MEMORY_SCOPE_AGENT); }
__device__ __forceinline__ unsigned xb_xcc_id() { return (unsigned)__builtin_amdgcn_s_getreg((3 << 11) | 20) & 0xFu; }
#define XB_SPIN(cond, bar) do { unsigned _sp = 0; while (cond) { __builtin_amdgcn_s_sleep(1); \
    if ((++_sp & 255u) == 0u) { if (xb_ld(&(bar)[XB_TMO])) break; if (_sp > XB_SPIN_CAP) { atomicAdd(&(bar)[XB_TMO], 1u); break; } } } } while (0)
struct XcdBarrier { unsigned* bar; unsigned x; volatile LAS unsigned* st; };
__device__ __forceinline__ XcdBarrier xcd_barrier_post(unsigned* bar, volatile LAS unsigned* st) {
    XcdBarrier b; b.bar = bar; b.x = xb_xcc_id(); b.st = st;
    if (threadIdx.x == 0) (void)xb_add(&bar[XB_XCNT(b.x)], 1u);
    return b;
}
__device__ __forceinline__ void xcd_barrier_complete(unsigned* bar, unsigned x, unsigned& nloc, unsigned& nx) {
    const unsigned G = gridDim.x * gridDim.y * gridDim.z;
    unsigned sum, cnt, mine, sp = 0u;
    for (;;) {
        sum = 0u; cnt = 0u; mine = 0u;
#pragma unroll
        for (unsigned j = 0; j < 16; ++j) { const unsigned c = xb_ld(&bar[XB_XCNT(j)]); sum += c; cnt += (c > 0u) ? 1u : 0u; mine = (j == x) ? c : mine; }
        if (sum == G) break;
        __builtin_amdgcn_s_sleep(1);
        if ((++sp & 255u) == 0u) { if (xb_ld(&bar[XB_TMO])) break; if (sp > XB_SPIN_CAP) { atomicAdd(&bar[XB_TMO], 1u); break; } }
    }
    nloc = mine > 0u ? mine : 1u; nx = cnt > 0u ? cnt : 1u;
}
__device__ __forceinline__ void xcd_barrier(const XcdBarrier& b) {
    asm volatile("s_waitcnt vmcnt(0)" ::: "memory");
    __syncthreads();
    if (threadIdx.x == 0) {
        unsigned* bar = b.bar;
        __builtin_amdgcn_s_waitcnt(0);
        unsigned nloc = b.st[0], nx = b.st[1];
        if (nloc == 0u) { xcd_barrier_complete(bar, b.x, nloc, nx); b.st[0] = nloc; b.st[1] = nx; }
        const unsigned old = xb_add(&bar[XB_XSUB(b.x)], 1u);
        const unsigned gen = old / nloc;
        if (old + 1u == (gen + 1u) * nloc) {
            __builtin_amdgcn_fence(__ATOMIC_RELEASE, "agent");
            asm volatile("s_waitcnt vmcnt(0)" ::: "memory");
            const unsigned og = xb_add(&bar[XB_TOP], 1u);
            const unsigned tg = og / nx;
            if (og + 1u == (tg + 1u) * nx) xb_add(&bar[XB_TOPGEN], 1u);
            else XB_SPIN(xb_ld(&bar[XB_TOPGEN]) == tg, bar);
            __builtin_amdgcn_fence(__ATOMIC_ACQUIRE, "agent");
            xb_add(&bar[XB_XGEN(b.x)], 1u);
            asm volatile("s_waitcnt vmcnt(0)" ::: "memory");
        } else {
            XB_SPIN(xb_ld(&bar[XB_XGEN(b.x)]) == gen, bar);
            __builtin_amdgcn_fence(__ATOMIC_ACQUIRE, "agent");
            asm volatile("s_waitcnt vmcnt(0)" ::: "memory");
        }
    }
    __syncthreads();
}

constexpr int NWAVES = 8;
struct Frame {
    LAS unsigned char* lds; int tid, lane, wave, vcu, G;
};

__device__ __forceinline__ int map_proj(int n) {
    if (n < 384) return n;
    if (n < 416) { const int j = n - 384; return 384 + (j >> 1) + 16 * (j & 1); }
    if (n < 512) return -1;
    if (n < 1536) { const int j = n - 512, hd = j >> 7, c = j & 127; return 416 + hd * 128 + (c >> 1) + 64 * (c & 1); }
    return n - 1536 + 1440;
}
__device__ __forceinline__ int map_uq(int n) { const int h = n / 96, c = n % 96; if (c < 64) return n; const int j = c - 64; return h * 96 + 64 + (j >> 1) + 16 * (j & 1); }
__device__ __forceinline__ int map_ffi(int n) { const int t = n >> 8, c = n & 255; return (c < 128) ? t * 128 + c : DFF + t * 128 + (c - 128); }

template <int MAP>
__device__ __forceinline__ void transpose_item(const float* W, int K, int Nsrc, int Ndst, const float* g, bf16* WT, int ldk, int koff, int row_off, LAS float* scr, int item, int lane) {
    const int nblk = Ndst / 32, kb = item / nblk, nb = item % nblk, k0 = 64 * kb, n0 = 32 * nb;
    const int nd = n0 + (lane & 31);
    const int ns = MAP == 0 ? nd : (MAP == 1 ? map_proj(nd) : (MAP == 2 ? map_uq(nd) : map_ffi(nd)));
#pragma unroll 8
    for (int i = 0; i < 32; ++i) { const int kk = 2 * i + (lane >> 5); float v = 0.f; if (ns >= 0) { v = W[(size_t)(k0 + kk) * Nsrc + ns]; if (g) v *= g[k0 + kk]; } scr[kk * 33 + (lane & 31)] = v; }
    asm volatile("s_waitcnt lgkmcnt(0)" ::: "memory");
    const int c = lane & 7;
#pragma unroll
    for (int j = 0; j < 4; ++j) { const int n = (lane >> 3) + 8 * j; const LAS float* s = scr + (8 * c) * 33 + n;
        u32x4 o; o.x = cvt_pk(s[0 * 33], s[1 * 33]); o.y = cvt_pk(s[2 * 33], s[3 * 33]); o.z = cvt_pk(s[4 * 33], s[5 * 33]); o.w = cvt_pk(s[6 * 33], s[7 * 33]);
        *(u32x4*)(WT + (size_t)(row_off + n0 + n) * ldk + koff + k0 + 8 * c) = o; }
    asm volatile("s_waitcnt lgkmcnt(0)" ::: "memory");
}
__device__ __forceinline__ void rms_row_to_bf16(const float* xrow, const float* g, bf16* orow, int lane) {
    const f32x4* xr = (const f32x4*)xrow + lane;
    f32x4 v[4]; float s = 0.f;
#pragma unroll
    for (int j = 0; j < 4; ++j) { v[j] = xr[64 * j]; s += (v[j][0] * v[j][0] + v[j][1] * v[j][1]) + (v[j][2] * v[j][2] + v[j][3] * v[j][3]); }
    const float inv = 1.0f / sqrtf(wave_sum(s) * (1.0f / D) + EPS);
    u32x2* o8 = (u32x2*)orow + lane;
#pragma unroll
    for (int j = 0; j < 4; ++j) { f32x4 w = v[j] * inv; if (g) w = w * ((const f32x4*)g)[lane + 64 * j]; u32x2 t; t.x = cvt_pk(w[0], w[1]); t.y = cvt_pk(w[2], w[3]); o8[64 * j] = t; }
}

struct Ptrs {
    const float *x, *mem; const int* pos; const float *g_mix, *w_in, *g_q_lat, *w_uq, *g_kv_lat, *w_ukv, *w_out, *g_xattn, *g_mem, *w_xq, *w_xkv, *w_xo, *g_ffn, *w_ffn_in, *conv_w, *conv_b, *w_ffn_out, *g_final;
    float* out; unsigned char* ws;
};

__device__ __forceinline__ void p0_prologue(const Frame& F, const Ptrs& P) {
    LAS float* scr = (LAS float*)(F.lds + F.wave * 16384);
    const int gw = F.vcu * NWAVES + F.wave, NGW = F.G * NWAVES, lane = F.lane;
    unsigned char* ws = P.ws;
    bf16* Win = (bf16*)(ws + WS_WIN); bf16* Wup = (bf16*)(ws + WS_WUP);
    for (int i = gw * 64 + lane; i < 768 * 16 + 1024 * 32; i += NGW * 64) {
        if (i < 768 * 16) { const int r = i >> 4, c = i & 15; *(u32x4*)(Wup + (size_t)r * NLAT + 256 + 8 * c) = (u32x4){0u, 0u, 0u, 0u}; }
        else { const int j = i - 768 * 16, r = 768 + (j >> 5), c = j & 31; *(u32x4*)(Wup + (size_t)r * NLAT + 8 * c) = (u32x4){0u, 0u, 0u, 0u}; }
    }
    constexpr int I_IN = (D / 64) * (NPROJ / 32), I_UQ = (256 / 64) * (768 / 32), I_UKV = (128 / 64) * (1024 / 32), I_SQ = (D / 64) * (D / 32), I_XKV = (D / 64) * (2048 / 32), I_FFI = (D / 64) * (NFF / 32), I_FFO = (DFF / 64) * (D / 32);
    constexpr int NITEMS = I_IN + I_UQ + I_UKV + 3 * I_SQ + I_XKV + I_FFI + I_FFO;
    for (int it = gw; it < NITEMS; it += NGW) {
        int r = it;
        if (r < I_IN) { transpose_item<1>(P.w_in, D, 2464, NPROJ, P.g_mix, Win, D, 0, 0, scr, r, lane); continue; } r -= I_IN;
        if (r < I_UQ) { transpose_item<2>(P.w_uq, 256, 768, 768, P.g_q_lat, Wup, NLAT, 0, 0, scr, r, lane); continue; } r -= I_UQ;
        if (r < I_UKV) { transpose_item<0>(P.w_ukv, 128, 1024, 1024, P.g_kv_lat, Wup, NLAT, 256, 768, scr, r, lane); continue; } r -= I_UKV;
        if (r < I_SQ) { transpose_item<0>(P.w_out, D, D, D, nullptr, (bf16*)(ws + WS_WOUT), D, 0, 0, scr, r, lane); continue; } r -= I_SQ;
        if (r < I_SQ) { transpose_item<0>(P.w_xq, D, D, D, P.g_xattn, (bf16*)(ws + WS_WXQ), D, 0, 0, scr, r, lane); continue; } r -= I_SQ;
        if (r < I_SQ) { transpose_item<0>(P.w_xo, D, D, D, nullptr, (bf16*)(ws + WS_WXO), D, 0, 0, scr, r, lane); continue; } r -= I_SQ;
        if (r < I_XKV) { transpose_item<0>(P.w_xkv, D, 2048, 2048, nullptr, (bf16*)(ws + WS_WXKV), D, 0, 0, scr, r, lane); continue; } r -= I_XKV;
        if (r < I_FFI) { transpose_item<3>(P.w_ffn_in, D, NFF, NFF, P.g_ffn, (bf16*)(ws + WS_WFFI), D, 0, 0, scr, r, lane); continue; } r -= I_FFI;
        transpose_item<0>(P.w_ffn_out, DFF, D, D, nullptr, (bf16*)(ws + WS_WFFO), DFF, 0, 0, scr, r, lane);
    }
    bf16* XN = (bf16*)(ws + WS_A); bf16* MEMN = (bf16*)(ws + WS_MEMN); float* CS = (float*)(ws + WS_CS);
    for (int m = gw; m < M + NB * 256; m += NGW) {
        if (m < M) rms_row_to_bf16(P.x + (size_t)m * D, nullptr, XN + (size_t)m * D, lane);
        else rms_row_to_bf16(P.mem + (size_t)(m - M) * D, P.g_mem, MEMN + (size_t)(m - M) * D, lane);
    }
    for (int m = gw; m < M; m += NGW) {
        const float inv_freq = exp2f(-(float)lane * (13.287712379549449f / 64.0f));
        const float ang = (float)P.pos[m] * inv_freq;
        *(f32x2*)(CS + (size_t)m * 128 + 2 * lane) = (f32x2){cosf(ang), sinf(ang)};
    }
}

template <int NDT, int VP>
__device__ __forceinline__ void flash_step(f32x16& X0, f32x16& X1, f32x16 (&O)[NDT], float& mrun, float& lrun, const LAS unsigned char* vbase, LAS float* wsf, int lane) {
    const int hi = lane >> 5;
    float rm = X0[0];
#pragma unroll
    for (int r = 1; r < 16; ++r) rm = fmaxf(rm, X0[r]);
#pragma unroll
    for (int r = 0; r < 16; ++r) rm = fmaxf(rm, X1[r]);
    rm = fmaxf(rm, __shfl_xor(rm, 32));
    const float mnew = fmaxf(mrun, rm);
    const float alpha = __builtin_amdgcn_exp2f(mrun - mnew);
    mrun = mnew;
    float ps = 0.f;
#pragma unroll
    for (int r = 0; r < 16; ++r) { X0[r] = __builtin_amdgcn_exp2f(X0[r] - mnew); X1[r] = __builtin_amdgcn_exp2f(X1[r] - mnew); ps += X0[r] + X1[r]; }
    lrun = lrun * alpha + ps;
    if (__any(alpha != 1.0f)) {
        if (hi == 0) wsf[lane] = alpha;
        asm volatile("s_waitcnt lgkmcnt(0)" ::: "memory");
#pragma unroll
        for (int r = 0; r < 16; ++r) { const float a = wsf[crow(r, hi)];
#pragma unroll
            for (int dt = 0; dt < NDT; ++dt) O[dt][r] *= a; }
        asm volatile("s_waitcnt lgkmcnt(0)" ::: "memory");
    }
    const bf16x8 pa0 = pack8(X0[0], X0[1], X0[2], X0[3], X0[4], X0[5], X0[6], X0[7]), pa1 = pack8(X0[8], X0[9], X0[10], X0[11], X0[12], X0[13], X0[14], X0[15]);
    const bf16x8 pa2 = pack8(X1[0], X1[1], X1[2], X1[3], X1[4], X1[5], X1[6], X1[7]), pa3 = pack8(X1[8], X1[9], X1[10], X1[11], X1[12], X1[13], X1[14], X1[15]);
    const LAS unsigned char* vl = vbase + (4 * hi + ((lane & 15) >> 2)) * VP + (16 * ((lane >> 4) & 1) + 4 * (lane & 3)) * 2;
#pragma unroll
    for (int dt = 0; dt < NDT; ++dt) {
        const bf16x8 v0 = tr_frag(vl + 0 * 16 * VP + dt * 64, vl + (0 * 16 + 8) * VP + dt * 64);
        const bf16x8 v1 = tr_frag(vl + 1 * 16 * VP + dt * 64, vl + (1 * 16 + 8) * VP + dt * 64);
        const bf16x8 v2 = tr_frag(vl + 2 * 16 * VP + dt * 64, vl + (2 * 16 + 8) * VP + dt * 64);
        const bf16x8 v3 = tr_frag(vl + 3 * 16 * VP + dt * 64, vl + (3 * 16 + 8) * VP + dt * 64);
        O[dt] = MFMA32(pa0, v0, O[dt]); O[dt] = MFMA32(pa1, v1, O[dt]); O[dt] = MFMA32(pa2, v2, O[dt]); O[dt] = MFMA32(pa3, v3, O[dt]);
    }
}
template <int NDT>
__device__ __forceinline__ void flash_store(f32x16 (&O)[NDT], float lrun, LAS float* wsf, int lane, bf16* out, size_t ldo) {
    const int hi = lane >> 5;
    lrun += __shfl_xor(lrun, 32);
    if (hi == 0) wsf[lane] = 1.0f / lrun;
    asm volatile("s_waitcnt lgkmcnt(0)" ::: "memory");
#pragma unroll
    for (int r = 0; r < 16; ++r) { const float a = wsf[crow(r, hi)];
#pragma unroll
        for (int dt = 0; dt < NDT; ++dt) { const unsigned w = cvt_pk(O[dt][r] * a, 0.f); *at(out, (unsigned)(crow(r, hi) * (int)ldo + 32 * dt + (lane & 31)) * 2u) = (bf16)(w & 0xffffu); } }
    asm volatile("s_waitcnt lgkmcnt(0)" ::: "memory");
}

constexpr int MLA_VP = 192;
__device__ __forceinline__ void mla_unit(const Frame& F, int b, int h, int qb, const bf16* QKV, const bf16* KR, bf16* Y) {
    int tid = F.tid; asm volatile("" : "+v"(tid));
    const int lane = tid & 63, wid = F.wave, r32 = lane & 31, hi = lane >> 5;
    LAS unsigned char* vt = F.lds;
    LAS float* wsf = (LAS float*)(F.lds + 2 * 64 * MLA_VP) + wid * 32;
    const size_t rb = (size_t)b * SEQ; const int q0 = qb * 256;
    const int qrow = q0 + 32 * wid + r32;
    bf16x8 qf[6];
#pragma unroll
    for (int s = 0; s < 6; ++s) qf[s] = *(const bf16x8*)at(QKV + (rb + q0 + 32 * wid) * NUP + h * 96, (unsigned)(r32 * NUP + 16 * s + 8 * hi) * 2u);
    const int NT = (q0 + 256) / 64;
    const int tmax = q0 / 64 + (wid >> 1);
    const bf16* vsrc = QKV + rb * NUP + 768 + h * 128 + 64;
    const unsigned voff = (unsigned)((tid >> 3) * NUP + (tid & 7) * 8) * 2u;
    const int vdst = (tid >> 3) * MLA_VP + (tid & 7) * 16;
    const unsigned koff = (unsigned)(r32 * NUP + 8 * hi) * 2u, kroff = (unsigned)(r32 * 32 + 8 * hi) * 2u;
    u32x4 vreg = *(const u32x4*)at(vsrc, voff);
    *(LAS u32x4*)(vt + vdst) = vreg;
    __syncthreads();
    float mrun = -1e30f, lrun = 0.f; f32x16 O[2]; O[0] = (f32x16){}; O[1] = (f32x16){};
    for (int t = 0; t < NT; ++t) {
        if (t + 1 < NT) vreg = *(const u32x4*)at(vsrc + (size_t)(t + 1) * 64 * NUP, voff);
        if (t <= tmax) {
            f32x16 X0 = (f32x16){}, X1 = (f32x16){};
            const bf16* kp = at(QKV + (rb + 64 * t) * NUP + 768 + h * 128, koff);
            const bf16* kp1 = at(QKV + (rb + 64 * t + 32) * NUP + 768 + h * 128, koff);
            const bf16* krp = at(KR + (rb + 64 * t) * 32, kroff);
#pragma unroll
            for (int s = 0; s < 6; ++s) {
                const bf16x8 k0 = (s < 4) ? *(const bf16x8*)(kp + 16 * s) : *(const bf16x8*)(krp + 16 * (s - 4));
                const bf16x8 k1 = (s < 4) ? *(const bf16x8*)(kp1 + 16 * s) : *(const bf16x8*)(krp + 32 * 32 + 16 * (s - 4));
                X0 = MFMA32(k0, qf[s], X0); X1 = MFMA32(k1, qf[s], X1);
            }
            if (64 * t + 63 > q0 + 32 * wid) {
#pragma unroll
                for (int r = 0; r < 16; ++r) { const int kk = 64 * t + crow(r, hi); if (kk > qrow) X0[r] = -INFINITY; if (kk + 32 > qrow) X1[r] = -INFINITY; }
            }
            flash_step<2, MLA_VP>(X0, X1, O, mrun, lrun, vt + (t & 1) * 64 * MLA_VP, wsf, lane);
        }
        if (t + 1 < NT) *(LAS u32x4*)(vt + ((t + 1) & 1) * 64 * MLA_VP + vdst) = vreg;
        __syncthreads();
    }
    flash_store<2>(O, lrun, wsf, lane, Y + (rb + q0 + 32 * wid) * D + h * 64, D);
    __syncthreads();
}

constexpr int XA_VP = 320;
__device__ __forceinline__ void xattn_unit(const Frame& F, int pm, int h, const bf16* QX, const bf16* MKV, bf16* OX) {
    int tid = F.tid; asm volatile("" : "+v"(tid));
    const int lane = tid & 63, wid = F.wave, r32 = lane & 31, hi = lane >> 5;
    LAS unsigned char* vt = F.lds;
    LAS float* wsf = (LAS float*)(F.lds + 256 * XA_VP) + wid * 32;
    const int b = pm >> 4;
    const size_t row0 = (size_t)pm * 256 + 32 * wid;
    const bf16* qp = at(QX + row0 * D + h * 256, (unsigned)(r32 * D + 8 * hi) * 2u);
    const bf16* kbase = MKV + (size_t)b * 256 * 2048 + h * 256;
#pragma unroll 1
    for (int dh = 0; dh < 2; ++dh) {
#pragma unroll
        for (int i = 0; i < 8; ++i) { const int p = tid + 512 * i, key = p >> 4, ch = p & 15;
            *(LAS u32x4*)(vt + key * XA_VP + ch * 16) = *(const u32x4*)at(kbase + 1024 + dh * 128, (unsigned)(key * 2048 + ch * 8) * 2u); }
        __syncthreads();
        float mrun = -1e30f, lrun = 0.f; f32x16 O[4]; O[0] = (f32x16){}; O[1] = (f32x16){}; O[2] = (f32x16){}; O[3] = (f32x16){};
#pragma unroll 1
        for (int t = 0; t < 4; ++t) {
            f32x16 X0 = (f32x16){}, X1 = (f32x16){};
            const bf16* kp = at(kbase + (size_t)(64 * t) * 2048, (unsigned)(r32 * 2048 + 8 * hi) * 2u);
            const bf16* kp1 = at(kbase + (size_t)(64 * t + 32) * 2048, (unsigned)(r32 * 2048 + 8 * hi) * 2u);
#pragma unroll
            for (int s = 0; s < 16; ++s) { const bf16x8 q = *(const bf16x8*)(qp + 16 * s), k0 = *(const bf16x8*)(kp + 16 * s), k1 = *(const bf16x8*)(kp1 + 16 * s); X0 = MFMA32(k0, q, X0); X1 = MFMA32(k1, q, X1);
                if ((s & 3) == 3) __builtin_amdgcn_sched_barrier(0); }
            flash_step<4, XA_VP>(X0, X1, O, mrun, lrun, vt + 64 * t * XA_VP, wsf, lane);
        }
        flash_store<4>(O, lrun, wsf, lane, OX + row0 * D + h * 256 + dh * 128, D);
        __syncthreads();
    }
}

constexpr int RT_VP = 320;
__device__ __forceinline__ void stage_tile128(LAS unsigned char* dst, const bf16* src, size_t ld, int tid) {
#pragma unroll
    for (int i = 0; i < 4; ++i) { const int p = tid + 512 * i, row = p >> 4, ch = p & 15; *(LAS u32x4*)(dst + row * RT_VP + ch * 16) = *(const u32x4*)at(src, (unsigned)(row * (int)ld + ch * 8) * 2u); }
}
__device__ __forceinline__ void ret_kv_unit(const Frame& F, int U, const bf16* RK, const bf16* RV, float* KVT) {
    int tid = F.tid; asm volatile("" : "+v"(tid));
    const int lane = tid & 63, wid = F.wave, hi = lane >> 5;
    const int bh = U >> 5, c = U & 31, b = bh >> 2, h = bh & 3;
    const size_t t0 = (size_t)b * SEQ + c * 128;
    LAS unsigned char* kt = F.lds; LAS unsigned char* vt = F.lds + 128 * RT_VP;
    stage_tile128(kt, RK + t0 * 512 + h * 128, 512, tid); stage_tile128(vt, RV + t0 * 512 + h * 128, 512, tid);
    __syncthreads();
    const int dvb = wid >> 1, dk0 = 2 * (wid & 1);
    f32x16 acc0 = (f32x16){}, acc1 = (f32x16){};
    const int lo = (8 * hi + ((lane & 15) >> 2)) * RT_VP + (16 * ((lane >> 4) & 1) + 4 * (lane & 3)) * 2;
#pragma unroll
    for (int s = 0; s < 8; ++s) {
        const bf16x8 af = tr_frag(vt + lo + 16 * s * RT_VP + dvb * 64, vt + lo + (16 * s + 4) * RT_VP + dvb * 64);
        const bf16x8 b0 = tr_frag(kt + lo + 16 * s * RT_VP + dk0 * 64, kt + lo + (16 * s + 4) * RT_VP + dk0 * 64);
        const bf16x8 b1 = tr_frag(kt + lo + 16 * s * RT_VP + (dk0 + 1) * 64, kt + lo + (16 * s + 4) * RT_VP + (dk0 + 1) * 64);
        acc0 = MFMA32(af, b0, acc0); acc1 = MFMA32(af, b1, acc1);
    }
    float* o = KVT + (size_t)U * 16384 + (size_t)(32 * dvb) * 128 + 32 * dk0;
#pragma unroll
    for (int r = 0; r < 16; ++r) { *at(o, (unsigned)(crow(r, hi) * 128 + (lane & 31)) * 4u) = acc0[r]; *at(o, (unsigned)(crow(r, hi) * 128 + 32 + (lane & 31)) * 4u) = acc1[r]; }
    __syncthreads();
}
__device__ __forceinline__ void ret_scan(const Frame& F, float* KVT) {
    const int gt = F.vcu * 512 + F.tid, NT = F.G * 512;
    for (int i = gt; i < 16 * 16384; i += NT) {
        const int bh = i >> 14, e = i & 16383, h = bh & 3;
        const float lg = __builtin_amdgcn_logf(1.0f - __builtin_amdgcn_exp2f(-5.0f - (float)h));
        const float dec = __builtin_amdgcn_exp2f(128.0f * lg);
        const unsigned po = (unsigned)(bh * 32 * 16384 + e) * 4u; float st = 0.f;
#pragma unroll 8
        for (int c = 0; c < 32; ++c) { float* p = at(KVT, po + (unsigned)c * 65536u); const float v = *p; *p = st; st = dec * st + v; }
    }
}
__device__ __forceinline__ void ret_out_pair(const Frame& F, int pair, const bf16* RQ, const bf16* RK, const bf16* RV, const bf16* RG, const float* KVT, bf16* Y) {
    int tid = F.tid; asm volatile("" : "+v"(tid));
    const int lane = tid & 63, wid = F.wave, r32 = lane & 31, hi = lane >> 5;
    const int u = wid >> 2, ib = wid & 3, U = 2 * pair + u;
    const int bh = U >> 5, c = U & 31, b = bh >> 2, h = bh & 3;
    const size_t t0 = (size_t)b * SEQ + c * 128;
    {
        const int U0 = 2 * pair, bh0 = U0 >> 5, c0 = U0 & 31; const size_t s0 = (size_t)(bh0 >> 2) * SEQ + c0 * 128;
        stage_tile128(F.lds, RV + s0 * 512 + (bh0 & 3) * 128, 512, tid);
        const int U1 = U0 + 1, bh1 = U1 >> 5, c1 = U1 & 31; const size_t s1 = (size_t)(bh1 >> 2) * SEQ + c1 * 128;
        stage_tile128(F.lds + 128 * RT_VP, RV + s1 * 512 + (bh1 & 3) * 128, 512, tid);
    }
    __syncthreads();
    const LAS unsigned char* vt = F.lds + u * 128 * RT_VP;
    const float lg = __builtin_amdgcn_logf(1.0f - __builtin_amdgcn_exp2f(-5.0f - (float)h));
    bf16x8 qf[8];
#pragma unroll
    for (int s = 0; s < 8; ++s) qf[s] = *(const bf16x8*)at(RQ + (t0 + 32 * ib) * 512 + h * 128, (unsigned)(r32 * 512 + 16 * s + 8 * hi) * 2u);
    f32x16 acc[4]; acc[0] = (f32x16){}; acc[1] = (f32x16){}; acc[2] = (f32x16){}; acc[3] = (f32x16){};
    if (c > 0) {
        const float* pv = at(KVT + (size_t)U * 16384, (unsigned)(r32 * 128 + 8 * hi) * 4u);
#pragma unroll
        for (int s = 0; s < 8; ++s)
#pragma unroll
            for (int dt = 0; dt < 4; ++dt) { const f32x4 a = *(const f32x4*)(pv + (size_t)dt * 32 * 128 + 16 * s), bq = *(const f32x4*)(pv + (size_t)dt * 32 * 128 + 16 * s + 4);
                acc[dt] = MFMA32(qf[s], pack8(a[0], a[1], a[2], a[3], bq[0], bq[1], bq[2], bq[3]), acc[dt]); }
#pragma unroll
        for (int r = 0; r < 16; ++r) { const float sc = __builtin_amdgcn_exp2f((float)(32 * ib + crow(r, hi) + 1) * lg);
#pragma unroll
            for (int dt = 0; dt < 4; ++dt) acc[dt][r] *= sc; }
    }
    const float colsc = __builtin_amdgcn_exp2f((float)(32 * ib + r32 - 127) * lg);
    const int vlo = (4 * hi + ((lane & 15) >> 2)) * RT_VP + (16 * ((lane >> 4) & 1) + 4 * (lane & 3)) * 2;
#pragma unroll 1
    for (int jb = 0; jb <= ib; ++jb) {
        f32x16 X = (f32x16){};
        const bf16* kp = at(RK + (t0 + 32 * jb) * 512 + h * 128, (unsigned)(r32 * 512 + 8 * hi) * 2u);
#pragma unroll
        for (int s = 0; s < 8; ++s) X = MFMA32(*(const bf16x8*)(kp + 16 * s), qf[s], X);
#pragma unroll
        for (int r = 0; r < 16; ++r) { X[r] *= colsc; if (jb == ib && crow(r, hi) > r32) X[r] = 0.f; }
        const bf16x8 pa0 = pack8(X[0], X[1], X[2], X[3], X[4], X[5], X[6], X[7]), pa1 = pack8(X[8], X[9], X[10], X[11], X[12], X[13], X[14], X[15]);
        const LAS unsigned char* vb = vt + vlo + 32 * jb * RT_VP;
#pragma unroll
        for (int dt = 0; dt < 4; ++dt) {
            const bf16x8 v0 = tr_frag(vb + dt * 64, vb + 8 * RT_VP + dt * 64), v1 = tr_frag(vb + 16 * RT_VP + dt * 64, vb + 24 * RT_VP + dt * 64);
            acc[dt] = MFMA32(pa0, v0, acc[dt]); acc[dt] = MFMA32(pa1, v1, acc[dt]);
        }
    }
#pragma unroll
    for (int r = 0; r < 16; ++r) {
        float s1 = (acc[0][r] + acc[1][r]) + (acc[2][r] + acc[3][r]);
        float s2 = (acc[0][r] * acc[0][r] + acc[1][r] * acc[1][r]) + (acc[2][r] * acc[2][r] + acc[3][r] * acc[3][r]);
#pragma unroll
        for (int o = 1; o < 32; o <<= 1) { s1 += __shfl_xor(s1, o); s2 += __shfl_xor(s2, o); }
        const float mean = s1 * (1.0f / 128.0f), var = fmaxf(s2 * (1.0f / 128.0f) - mean * mean, 0.f), rstd = 1.0f / sqrtf(var + EPS);
        const int rl = crow(r, hi);
#pragma unroll
        for (int dt = 0; dt < 4; ++dt) { const float g = bf2f(*at(RG + (t0 + 32 * ib) * 512 + h * 128, (unsigned)(rl * 512 + 32 * dt + r32) * 2u));
            const unsigned w = cvt_pk((acc[dt][r] - mean) * rstd * g, 0.f); *at(Y + (t0 + 32 * ib) * D + 512 + h * 128, (unsigned)(rl * D + 32 * dt + r32) * 2u) = (bf16)(w & 0xffffu); }
    }
    __syncthreads();
}

constexpr int N_PHASES = 12;
struct Args { const void* in[21]; float* out; unsigned char* ws; int ph_lo, ph_hi; };
__global__ void __launch_bounds__(NWAVES * 64, 2) hymba_fwd(Args args) {
    extern __shared__ __attribute__((aligned(16))) unsigned char lds_raw[];
    Frame F;
    F.lds = (LAS unsigned char*)lds_raw;
    F.tid = threadIdx.x; F.lane = F.tid & 63; F.wave = __builtin_amdgcn_readfirstlane(F.tid >> 6);
    F.G = gridDim.x; { const int bx = blockIdx.x; F.vcu = (F.G % 8 == 0) ? (bx % 8) * (F.G / 8) + bx / 8 : bx; }
    Ptrs P;
    P.x = (const float*)args.in[0]; P.mem = (const float*)args.in[1]; P.pos = (const int*)args.in[2]; P.g_mix = (const float*)args.in[3]; P.w_in = (const float*)args.in[4];
    P.g_q_lat = (const float*)args.in[5]; P.w_uq = (const float*)args.in[6]; P.g_kv_lat = (const float*)args.in[7]; P.w_ukv = (const float*)args.in[8]; P.w_out = (const float*)args.in[9];
    P.g_xattn = (const float*)args.in[10]; P.g_mem = (const float*)args.in[11]; P.w_xq = (const float*)args.in[12]; P.w_xkv = (const float*)args.in[13]; P.w_xo = (const float*)args.in[14];
    P.g_ffn = (const float*)args.in[15]; P.w_ffn_in = (const float*)args.in[16]; P.conv_w = (const float*)args.in[17]; P.conv_b = (const float*)args.in[18]; P.w_ffn_out = (const float*)args.in[19];
    P.g_final = (const float*)args.in[20]; P.out = args.out; P.ws = args.ws;
    unsigned char* ws = args.ws;
    gu32* ctl = (gu32*)(ws + WS_CTL);
    volatile LAS unsigned* MISC = (volatile LAS unsigned*)(F.lds + MISC_OFF);
    for (int u = F.tid; u < (LDS_BYTES - LDSCTL_OFF) / 4; u += NWAVES * 64) ((LAS unsigned*)(F.lds + LDSCTL_OFF))[u] = 0u;
    __syncthreads();
    XcdBarrier bar; bar.bar = (unsigned*)(ctl + CW_BAR); bar.x = 0; bar.st = nullptr;
    if (MK_N_LAUNCHES == 1) bar = xcd_barrier_post((unsigned*)(ctl + CW_BAR), MISC + 8);
    const int lo = args.ph_lo, hi_ph = args.ph_hi;
#ifndef PH_MASK
#define PH_MASK 0xFFF
#endif
#define IN(k) ((((PH_MASK) >> (k)) & 1) && lo <= (k) && (k) < hi_ph)
#define SEAM(k) do { if (IN(k) && IN((k) + 1)) xcd_barrier(bar); } while (0)

    bf16* Win = (bf16*)(ws + WS_WIN); bf16* Wup = (bf16*)(ws + WS_WUP); bf16* Wout = (bf16*)(ws + WS_WOUT); bf16* Wxq = (bf16*)(ws + WS_WXQ); bf16* Wxkv = (bf16*)(ws + WS_WXKV);
    bf16* Wxo = (bf16*)(ws + WS_WXO); bf16* Wffi = (bf16*)(ws + WS_WFFI); bf16* Wffo = (bf16*)(ws + WS_WFFO);
    float* CS = (float*)(ws + WS_CS); float* SSQL = (float*)(ws + WS_SSQL); float* SSQ1 = (float*)(ws + WS_SSQ1); float* SSQ2 = (float*)(ws + WS_SSQ2);
    bf16* MEMN = (bf16*)(ws + WS_MEMN); bf16* MKV = (bf16*)(ws + WS_MKV);
    bf16* XN = (bf16*)(ws + WS_A); bf16* Y = (bf16*)(ws + WS_A); bf16* XB2 = (bf16*)(ws + WS_A);
    bf16* LAT = (bf16*)(ws + WS_LAT); bf16* KR = (bf16*)(ws + WS_KR); bf16* RQ = (bf16*)(ws + WS_RQ); bf16* RK = (bf16*)(ws + WS_RK); bf16* RV = (bf16*)(ws + WS_RV); bf16* RG = (bf16*)(ws + WS_RG);
    bf16* QKV = (bf16*)(ws + WS_C); float* KVT = (float*)(ws + WS_KVT);
    bf16* XB1 = (bf16*)(ws + WS_XB1); bf16* HB = (bf16*)(ws + WS_H); bf16* QX = (bf16*)(ws + WS_QX); bf16* OX = (bf16*)(ws + WS_OX);
    const int bx = (int)blockIdx.x;

    if (IN(0)) { p0_prologue(F, P); }
    SEAM(0);
    if (IN(1)) {
        pg8::Gemm g{XN, Win, D, 64}; pg8::StaticOrder S; S.init(M / 256, NPROJ / 256, F.G, bx);
        EpiProj E{LAT, KR, RQ, RK, RV, RG, SSQL, CS};
        pg8::gemm_phase(F.lds, g, S, E);
    }
    SEAM(1);
    if (IN(2)) {
        { pg8::Gemm g{LAT, Wup, NLAT, 64}; pg8::StaticOrder S; S.init(M / 256, NUP / 256, F.G, bx); EpiUp E{QKV, SSQL, CS}; pg8::gemm_phase(F.lds, g, S, E); }
        { pg8::Gemm g{MEMN, Wxkv, D, 64}; pg8::StaticOrder S; S.init(4, 8, F.G, (bx + 64) % F.G); EpiStore E{MKV, 2048, nullptr, 1.0f}; pg8::gemm_phase(F.lds, g, S, E); }
        __syncthreads();
        for (int U = F.vcu; U < 512; U += F.G) ret_kv_unit(F, U, RK, RV, KVT);
    }
    SEAM(2);
    if (IN(3)) {
        ret_scan(F, KVT);
        for (int v = F.vcu; v < 256; v += F.G) { const int bh = v >> 3, s = v & 7;
            mla_unit(F, bh >> 3, bh & 7, 15 - s, QKV, KR, Y); mla_unit(F, bh >> 3, bh & 7, s, QKV, KR, Y); }
    }
    SEAM(3);
    if (IN(4)) { for (int p = F.vcu; p < 256; p += F.G) ret_out_pair(F, p, RQ, RK, RV, RG, KVT, Y); }
    SEAM(4);
    if (IN(5)) { pg8::Gemm g{Y, Wout, D, 64}; pg8::StaticOrder S; S.init(M / 256, 4, F.G, bx); EpiRes E{P.x, P.out, XB1, SSQ1}; pg8::gemm_phase(F.lds, g, S, E); }
    SEAM(5);
    if (IN(6)) { pg8::Gemm g{XB1, Wxq, D, 64}; pg8::StaticOrder S; S.init(M / 256, 4, F.G, bx); EpiStore E{QX, D, SSQ1, C2_X}; pg8::gemm_phase(F.lds, g, S, E); }
    SEAM(6);
    if (IN(7)) { for (int u = F.vcu; u < 256; u += F.G) xattn_unit(F, u >> 2, u & 3, QX, MKV, OX); }
    SEAM(7);
    if (IN(8)) { pg8::Gemm g{OX, Wxo, D, 64}; pg8::StaticOrder S; S.init(M / 256, 4, F.G, bx); EpiRes E{P.out, P.out, XB2, SSQ2}; pg8::gemm_phase(F.lds, g, S, E); }
    SEAM(8);
    if (IN(9)) { pg8::Gemm g{XB2 - 2 * D, Wffi, D, FF_BLK}; pg8::StaticOrder S; S.init(FF_NM, NFF / 256, F.G, bx); EpiFfn E{HB, SSQ2, P.conv_w, P.conv_b}; pg8::gemm_phase(F.lds, g, S, E); }
    SEAM(9);
    if (IN(10)) { pg8::Gemm g{HB, Wffo, DFF, 64}; pg8::StaticOrder S; S.init(M / 256, 4, F.G, bx); EpiRes E{P.out, P.out, nullptr, nullptr}; pg8::gemm_phase(F.lds, g, S, E); }
    SEAM(10);
    if (IN(11)) {
        const int gw = F.vcu * NWAVES + F.wave, NGW = F.G * NWAVES, lane = F.lane;
        for (int m = gw; m < M; m += NGW) {
            f32x4* xr = (f32x4*)(P.out + (size_t)m * D) + lane; f32x4 v[4]; float s = 0.f;
#pragma unroll
            for (int j = 0; j < 4; ++j) { v[j] = xr[64 * j]; s += (v[j][0] * v[j][0] + v[j][1] * v[j][1]) + (v[j][2] * v[j][2] + v[j][3] * v[j][3]); }
            const float inv = 1.0f / sqrtf(wave_sum(s) * (1.0f / D) + EPS);
#pragma unroll
            for (int j = 0; j < 4; ++j) xr[64 * j] = v[j] * inv * ((const f32x4*)P.g_final)[lane + 64 * j];
        }
    }
#undef IN
#undef SEAM
}

extern "C" void kernel_launch(void* const* d_in, const int* in_sizes, int n_in, void* d_out, int out_size, void* d_ws, size_t ws_size, hipStream_t stream) {
    static int grid = 0;
    if (grid == 0) {
        int dev = 0, cus = 0;
        if (n_in != 21 || out_size != M * D || ws_size < WS_END) { fprintf(stderr, "kernel_launch: unexpected problem (n_in %d, out %d, ws %zu); nothing launched\n", n_in, out_size, ws_size); grid = -1; return; }
        if (hipGetDevice(&dev) != hipSuccess || hipDeviceGetAttribute(&cus, hipDeviceAttributeMultiprocessorCount, dev) != hipSuccess) { grid = -1; return; }
        if (hipFuncSetAttribute((const void*)hymba_fwd, hipFuncAttributeMaxDynamicSharedMemorySize, LDS_BYTES) != hipSuccess) { fprintf(stderr, "kernel_launch: hipFuncSetAttribute failed\n"); grid = -1; return; }
        int per_cu = 0;
        if (hipOccupancyMaxActiveBlocksPerMultiprocessor(&per_cu, (const void*)hymba_fwd, NWAVES * 64, LDS_BYTES) != hipSuccess || per_cu < 1) fprintf(stderr, "kernel_launch: occupancy query says %d blocks per CU\n", per_cu);
        (void)hipGetLastError();
        grid = cus;
    }
    if (grid < 0) return;
    if (hipMemsetAsync((char*)d_ws + WS_CTL, 0, CTL_ZERO_BYTES, stream) != hipSuccess) return;
    Args a{};
    for (int i = 0; i < 21; ++i) a.in[i] = d_in[i];
    a.out = (float*)d_out; a.ws = (unsigned char*)d_ws;
    if (MK_N_LAUNCHES == 1) { a.ph_lo = 0; a.ph_hi = N_PHASES; hipLaunchKernelGGL(hymba_fwd, dim3(grid), dim3(NWAVES * 64), LDS_BYTES, stream, a); }
    else for (int p = 0; p < N_PHASES; ++p) { a.ph_lo = p; a.ph_hi = p + 1; hipLaunchKernelGGL(hymba_fwd, dim3(grid), dim3(NWAVES * 64), LDS_BYTES, stream, a); }
}
```

```cpp
#include <hip/hip_runtime.h>
#include <cstdio>
#include <cstdint>
#include <cmath>

#ifndef MK_N_LAUNCHES
#define MK_N_LAUNCHES 1
#endif

typedef unsigned short bf16;
typedef short bf16x8 __attribute__((ext_vector_type(8)));
typedef short s16x4 __attribute__((ext_vector_type(4)));
typedef float f32x4 __attribute__((ext_vector_type(4)));
typedef float f32x2 __attribute__((ext_vector_type(2)));
typedef float f32x16 __attribute__((ext_vector_type(16)));
typedef unsigned u32x4 __attribute__((ext_vector_type(4)));
typedef unsigned u32x2 __attribute__((ext_vector_type(2)));
#define LAS __attribute__((address_space(3)))
#define GAS __attribute__((address_space(1)))
typedef GAS unsigned gu32;

constexpr int NB = 4, SEQ = 4096, D = 1024, M = NB * SEQ;
constexpr int NPROJ = 2560;
constexpr int NLAT = 384;
constexpr int NUP = 1792;
constexpr int DFF = 2816, NFF = 2 * DFF;
constexpr float EPS = 1e-6f;
constexpr float LOG2E = 1.4426950408889634f;
constexpr float C2_MLA = 0.10206207261596575f * LOG2E;
constexpr float C2_X = 0.0625f * LOG2E;
constexpr float RET_KSCALE = 0.08838834764831845f;
constexpr int FF_BLK = 62, FF_TROWS = 4 * FF_BLK, FF_NM = (M + FF_TROWS - 1) / FF_TROWS;

constexpr size_t MiB = 1u << 20;
constexpr size_t WS_CTL = 0, CTL_ZERO_BYTES = 1 * MiB;
constexpr size_t WS_WIN = 1 * MiB;
constexpr size_t WS_WUP = 6 * MiB;
constexpr size_t WS_WOUT = 8 * MiB, WS_WXQ = 10 * MiB, WS_WXKV = 12 * MiB, WS_WXO = 16 * MiB;
constexpr size_t WS_WFFI = 18 * MiB;
constexpr size_t WS_WFFO = 29 * MiB;
constexpr size_t WS_CS = 35 * MiB;
constexpr size_t WS_SSQL = 43 * MiB;
constexpr size_t WS_SSQ1 = 44 * MiB, WS_SSQ2 = 45 * MiB;
constexpr size_t WS_MEMN = 46 * MiB, WS_MKV = 48 * MiB;
constexpr size_t WS_A = 52 * MiB;
constexpr size_t WS_B = 84 * MiB;
constexpr size_t WS_LAT = WS_B, WS_KR = WS_B + 12 * MiB, WS_RQ = WS_B + 13 * MiB, WS_RK = WS_B + 29 * MiB, WS_RV = WS_B + 45 * MiB, WS_RG = WS_B + 61 * MiB;
constexpr size_t WS_C = 161 * MiB;
constexpr size_t WS_KVT = 217 * MiB;
constexpr size_t WS_XB1 = WS_B, WS_H = WS_B, WS_QX = 172 * MiB, WS_OX = 204 * MiB;
constexpr size_t WS_END = 256 * MiB;
static_assert(WS_KVT + 32 * MiB <= WS_END && WS_OX + 32 * MiB <= WS_END && WS_H + (size_t)M * DFF * 2 <= WS_QX, "d_ws map");
constexpr int CW_TMO = 0, CW_BAR = 4096;

constexpr int RING_BYTES = 131072, LDSCTL_OFF = RING_BYTES, MISC_OFF = LDSCTL_OFF + 320, LDS_BYTES = 147456;

#define RLX_AGENT __ATOMIC_RELAXED, __HIP_MEMORY_SCOPE_AGENT
typedef __bf16 bf16x2_t __attribute__((ext_vector_type(2)));
__device__ __forceinline__ unsigned cvt_pk(float lo, float hi) { const f32x2 v = {lo, hi}; const bf16x2_t b = __builtin_convertvector(v, bf16x2_t); return __builtin_bit_cast(unsigned, b); }
__device__ __forceinline__ float bf2f(unsigned short b) { return __uint_as_float((unsigned)b << 16); }
__device__ __forceinline__ float wave_sum(float v) {
#pragma unroll
    for (int o = 1; o < 64; o <<= 1) v += __shfl_xor(v, o);
    return v;
}
__device__ __forceinline__ float silu_f(float x) { return x * __builtin_amdgcn_rcpf(1.0f + __builtin_amdgcn_exp2f(-x * LOG2E)); }
__device__ __forceinline__ int crow(int r, int hi) { return (r & 3) + 8 * (r >> 2) + 4 * hi; }
__device__ __forceinline__ bf16x8 pack8(float a0, float a1, float a2, float a3, float a4, float a5, float a6, float a7) {
    u32x4 w; w.x = cvt_pk(a0, a1); w.y = cvt_pk(a2, a3); w.z = cvt_pk(a4, a5); w.w = cvt_pk(a6, a7); return __builtin_bit_cast(bf16x8, w);
}
typedef short v4i16_t __attribute__((ext_vector_type(4)));
__device__ __forceinline__ s16x4 tr_read(const LAS unsigned char* p) { return __builtin_bit_cast(s16x4, __builtin_amdgcn_ds_read_tr16_b64_v4i16((LAS v4i16_t*)p)); }
__device__ __forceinline__ bf16x8 tr_frag(const LAS unsigned char* p0, const LAS unsigned char* p1) {
    const s16x4 lo = tr_read(p0), hi = tr_read(p1);
    return (bf16x8){lo[0], lo[1], lo[2], lo[3], hi[0], hi[1], hi[2], hi[3]};
}
template <class T> __device__ __forceinline__ T* at(T* base, unsigned byte_off) { return (T*)((char*)base + byte_off); }
template <class T> __device__ __forceinline__ const T* at(const T* base, unsigned byte_off) { return (const T*)((const char*)base + byte_off); }
#define MFMA32(a, b, c) __builtin_amdgcn_mfma_f32_32x32x16_bf16((a), (b), (c), 0, 0, 0)

namespace pg8 {
constexpr int BM = 256, BK = 64, HALF = 128, HTB = HALF * BK * 2, STAGE_BYTES = 8 * HTB, NXCD = 8, WGM = 8;
__host__ __device__ __forceinline__ int lds_byte(int r, int c) { const int st = (r >> 4) * 2 + (c >> 5), rr = r & 15, cc = c & 31, ob = rr * 64 + cc * 2; return st * 1024 + (ob ^ (((ob >> 9) & 1) << 5)); }
__host__ __device__ __forceinline__ void stage_rc(int b, int& R, int& C) { const int st = b / 1024, sb = b % 1024, swz = sb ^ (((sb >> 9) & 1) << 5); R = (st >> 1) * 16 + swz / 64; C = (st & 1) * 32 + (swz % 64) / 2; }
__host__ __device__ __forceinline__ int perm32(int rho) { const int n = rho >> 4, i = rho & 15; return 8 * (i >> 2) + 4 * n + (i & 3); }

struct Unit { int pm, pn; };
struct Gemm { const bf16* A; const bf16* Bt; int K; int a_blk; };

struct StaticOrder {
    int nM, nN, nwg, G, c;
    __device__ void init(int nM_, int nN_, int G_, int c_) { nM = nM_; nN = nN_; nwg = nM * nN; G = G_; c = c_; }
    __device__ bool next(int i, Unit& u) const {
        const long L = (long)i * G + c; if (L >= nwg) return false;
        int wgid = (int)L; { const int q = nwg / NXCD, r = nwg % NXCD, xcd = wgid % NXCD, off = wgid / NXCD; wgid = (xcd < r ? xcd * (q + 1) : r * (q + 1) + (xcd - r) * q) + off; }
        const int nig = WGM * nN, gid = wgid / nig, fm = gid * WGM, gsz = (nM - fm) < WGM ? (nM - fm) : WGM;
        u.pm = fm + ((wgid % nig) % gsz); u.pn = (wgid % nig) / gsz; return true;
    }
};

template <class Epi>
__device__ __forceinline__ void gemm_phase(LAS unsigned char* lds, const Gemm g, const StaticOrder& S, const Epi& E) {
    int tid = threadIdx.x; asm volatile("" : "+v"(tid));
    const int wid = __builtin_amdgcn_readfirstlane(tid >> 6), lane = tid & 63, wr = wid >> 2, wc = wid & 3, fr = lane & 15, fq = lane >> 4;
    const int K = g.K, nt = K / BK;
    unsigned voffA[2], voffB[2];
#pragma unroll
    for (int i = 0; i < 2; ++i) { int R, C; stage_rc(tid * 16 + i * 8192, R, C); const int Rb = (R & ~31) + perm32(R & 31); const int Ra = (R >> 6) * g.a_blk + (R & 63);
        voffA[i] = (unsigned)(Ra * K + C) * 2u; voffB[i] = (unsigned)(Rb * K + C) * 2u; }
    const size_t kstep = (size_t)(BK * 2);
    const size_t hstepA = (size_t)2 * g.a_blk * K * 2, tstepA = 2 * hstepA;
    const size_t hstepB = (size_t)HALF * K * 2, tstepB = 2 * hstepB;
    const unsigned ldsw = (unsigned)wid * 1024u;
    const int aoff = lds_byte(wr * 64 + fr, fq * 8), boff = lds_byte(wc * 32 + fr, fq * 8);
#define PG8_SA(b, h) (((b) * 2 + (h)) * HTB)
#define PG8_SB(b, h) ((4 + (b) * 2 + (h)) * HTB)
#define PG8_STAGE(bufoff, gbase, voff) do { _Pragma("unroll") for (int _i = 0; _i < 2; ++_i) \
        __builtin_amdgcn_global_load_lds((const unsigned*)((const char*)(gbase) + (voff)[_i]), (LAS unsigned*)(lds + (bufoff) + ldsw + _i * 8192), 16, 0, 0); } while (0)
#define PG8_LDA(dst, b, h) do { _Pragma("unroll") for (int m = 0; m < 4; ++m) _Pragma("unroll") for (int k = 0; k < 2; ++k) dst[m][k] = *(const LAS bf16x8*)(lds + PG8_SA(b, h) + aoff + m * 2048 + k * 1024); } while (0)
#define PG8_LDB(dst, b, h) do { _Pragma("unroll") for (int n = 0; n < 2; ++n) _Pragma("unroll") for (int k = 0; k < 2; ++k) dst[n][k] = *(const LAS bf16x8*)(lds + PG8_SB(b, h) + boff + n * 2048 + k * 1024); } while (0)
#define PG8_MMA(ai, bj, At, Bt) do { __builtin_amdgcn_s_setprio(1); _Pragma("unroll") for (int m = 0; m < 4; ++m) _Pragma("unroll") for (int n = 0; n < 2; ++n) _Pragma("unroll") for (int k = 0; k < 2; ++k) \
        acc[ai][bj][m][n] = __builtin_amdgcn_mfma_f32_16x16x32_bf16(Bt[n][k], At[m][k], acc[ai][bj][m][n], 0, 0, 0); __builtin_amdgcn_s_setprio(0); } while (0)
#define PG8_WAIT_V(n) asm volatile("s_waitcnt vmcnt(" #n ")" ::: "memory")
#define PG8_WAIT_L(n) asm volatile("s_waitcnt lgkmcnt(" #n ")" ::: "memory")
#define PG8_BAR __builtin_amdgcn_s_barrier()
#define PG8_SCHED __builtin_amdgcn_sched_barrier(0)
    Unit cur, nxt; int ui = 0;
    if (!S.next(0, cur)) return;
    f32x4 acc[2][2][4][2];
#pragma unroll
    for (int a = 0; a < 2; ++a)
#pragma unroll
        for (int b = 0; b < 2; ++b)
#pragma unroll
            for (int m = 0; m < 4; ++m)
#pragma unroll
                for (int n = 0; n < 2; ++n) acc[a][b][m][n] = (f32x4){0.f, 0.f, 0.f, 0.f};
    bf16x8 At[4][2], B0[2][2], B1[2][2];
    const char* cA = (const char*)g.A + (size_t)cur.pm * tstepA; const char* cB = (const char*)g.Bt + (size_t)cur.pn * tstepB;
    PG8_STAGE(PG8_SB(0, 0), cB, voffB); PG8_STAGE(PG8_SB(0, 1), cB + hstepB, voffB); PG8_STAGE(PG8_SA(0, 0), cA, voffA); PG8_STAGE(PG8_SA(0, 1), cA + hstepA, voffA);
    if (wr == 1) PG8_BAR;
    PG8_WAIT_V(2); PG8_BAR;
    PG8_STAGE(PG8_SB(1, 0), cB + kstep, voffB); PG8_STAGE(PG8_SA(1, 0), cA + kstep, voffA); PG8_STAGE(PG8_SB(1, 1), cB + hstepB + kstep, voffB);
    PG8_WAIT_V(6); PG8_BAR;
    for (;;) {
        const bool has_next = S.next(ui + 1, nxt);
        const char* nA = has_next ? (const char*)g.A + (size_t)nxt.pm * tstepA : cA; const char* nB = has_next ? (const char*)g.Bt + (size_t)nxt.pn * tstepB : cB;
#pragma unroll 1
        for (int t = 0; t < nt; t += 2) {
            const bool last = (t == nt - 2);
            const char* a1 = cA + (size_t)(t + 1) * kstep;
            const char* a2 = last ? nA : cA + (size_t)(t + 2) * kstep; const char* b2 = last ? nB : cB + (size_t)(t + 2) * kstep;
            const char* a3 = a2 + kstep; const char* b3 = b2 + kstep;
            PG8_LDB(B0, 0, 0); PG8_LDB(B1, 0, 1); PG8_SCHED; PG8_LDA(At, 0, 0); PG8_STAGE(PG8_SA(1, 1), a1 + hstepA, voffA);
            PG8_WAIT_V(8); PG8_WAIT_L(0); PG8_BAR; PG8_MMA(0, 0, At, B0); PG8_MMA(0, 1, At, B1); PG8_BAR; PG8_SCHED;
            PG8_LDA(At, 0, 1); PG8_STAGE(PG8_SB(0, 0), b2, voffB); PG8_STAGE(PG8_SB(0, 1), b2 + hstepB, voffB); PG8_STAGE(PG8_SA(0, 0), a2, voffA);
            PG8_WAIT_V(8); PG8_WAIT_L(0); PG8_BAR; PG8_MMA(1, 0, At, B0); PG8_MMA(1, 1, At, B1); PG8_BAR; PG8_SCHED;
            PG8_LDB(B0, 1, 0); PG8_LDB(B1, 1, 1); PG8_SCHED; PG8_LDA(At, 1, 0); PG8_STAGE(PG8_SA(0, 1), a2 + hstepA, voffA);
            PG8_WAIT_V(8); PG8_WAIT_L(0); PG8_BAR; PG8_MMA(0, 0, At, B0); PG8_MMA(0, 1, At, B1); PG8_BAR; PG8_SCHED;
            PG8_LDA(At, 1, 1); PG8_STAGE(PG8_SB(1, 0), b3, voffB); PG8_STAGE(PG8_SB(1, 1), b3 + hstepB, voffB); PG8_STAGE(PG8_SA(1, 0), a3, voffA);
            PG8_WAIT_V(8); PG8_WAIT_L(0); PG8_BAR; PG8_MMA(1, 0, At, B0); PG8_MMA(1, 1, At, B1); PG8_BAR; PG8_SCHED;
        }
        if (wr == 0) PG8_BAR;
        E(acc, cur, wr, wc, fr, fq);
        if (!has_next) break;
#pragma unroll
        for (int a = 0; a < 2; ++a)
#pragma unroll
            for (int b = 0; b < 2; ++b)
#pragma unroll
                for (int m = 0; m < 4; ++m)
#pragma unroll
                    for (int n = 0; n < 2; ++n) acc[a][b][m][n] = (f32x4){0.f, 0.f, 0.f, 0.f};
        cur = nxt; cA = nA; cB = nB; ++ui;
        if (wr == 1) PG8_BAR;
    }
    PG8_WAIT_V(0);
    PG8_BAR;
#undef PG8_SA
#undef PG8_SB
#undef PG8_STAGE
#undef PG8_LDA
#undef PG8_LDB
#undef PG8_MMA
#undef PG8_WAIT_V
#undef PG8_WAIT_L
#undef PG8_BAR
#undef PG8_SCHED
}
}

typedef f32x4 Acc[2][2][4][2];
__device__ __forceinline__ void st8bf(bf16* p, const f32x4 a, const f32x4 b) { u32x4 w; w.x = cvt_pk(a[0], a[1]); w.y = cvt_pk(a[2], a[3]); w.z = cvt_pk(b[0], b[1]); w.w = cvt_pk(b[2], b[3]); *(u32x4*)p = w; }
__device__ __forceinline__ float ssq8(const f32x4 a, const f32x4 b) { return (a[0] * a[0] + a[1] * a[1]) + (a[2] * a[2] + a[3] * a[3]) + (b[0] * b[0] + b[1] * b[1]) + (b[2] * b[2] + b[3] * b[3]); }
__device__ __forceinline__ float red_fq(float s) { s += __shfl_xor(s, 16); s += __shfl_xor(s, 32); return s; }
__device__ __forceinline__ f32x4 rot2(const f32x4 v, const f32x4 cs) { return (f32x4){v[0] * cs[0] - v[1] * cs[1], v[1] * cs[0] + v[0] * cs[1], v[2] * cs[2] - v[3] * cs[3], v[3] * cs[2] + v[2] * cs[3]}; }

struct EpiProj {
    bf16 *LAT, *KR, *RQ, *RK, *RV, *RG; float* SSQL; const float* CS;
    __device__ __forceinline__ void operator()(const Acc& acc, const pg8::Unit& u, int wr, int wc, int fr, int fq) const {
        const int pn = u.pn;
#pragma unroll
        for (int ai = 0; ai < 2; ++ai)
#pragma unroll
            for (int m = 0; m < 4; ++m) {
                const int row = u.pm * 256 + ai * 128 + wr * 64 + m * 16 + fr;
                const int cw = 32 * wc + 8 * fq;
                if (pn == 0) {
                    float s = 0.f;
#pragma unroll
                    for (int bj = 0; bj < 2; ++bj) { st8bf(at(LAT, (unsigned)(row * NLAT + bj * 128 + cw) * 2u), acc[ai][bj][m][0], acc[ai][bj][m][1]); s += ssq8(acc[ai][bj][m][0], acc[ai][bj][m][1]); }
                    s = red_fq(s); if (fq == 0) *at(SSQL, (unsigned)(row * 8 + wc) * 4u) = s;
                } else if (pn == 1) {
                    st8bf(at(LAT, (unsigned)(row * NLAT + 256 + cw) * 2u), acc[ai][0][m][0], acc[ai][0][m][1]);
                    float s = red_fq(ssq8(acc[ai][0][m][0], acc[ai][0][m][1])); if (fq == 0) *at(SSQL, (unsigned)(row * 8 + 4 + wc) * 4u) = s;
                    if (wc == 0) {
                        const float* cs = at(CS, (unsigned)row * 512u);
                        f32x4 o[2];
#pragma unroll
                        for (int n = 0; n < 2; ++n) { const int i0 = 4 * fq + 2 * n; const f32x2 a = *(const f32x2*)(cs + 8 * i0), b = *(const f32x2*)(cs + 8 * i0 + 8);
                            o[n] = rot2(acc[ai][1][m][n], (f32x4){a[0], a[1], b[0], b[1]}); }
                        st8bf(at(KR, (unsigned)(row * 32 + 8 * fq) * 2u), o[0], o[1]);
                    }
                } else if (pn < 6) {
                    const float* cs = at(CS, (unsigned)row * 512u);
#pragma unroll
                    for (int bj = 0; bj < 2; ++bj) { const int head = 2 * (pn & 1) + bj; f32x4 o[2];
#pragma unroll
                        for (int n = 0; n < 2; ++n) { const int i0 = (cw + 4 * n) >> 1; o[n] = rot2(acc[ai][bj][m][n], *(const f32x4*)(cs + 2 * i0)); }
                        if (pn < 4) st8bf(at(RQ, (unsigned)(row * 512 + head * 128 + cw) * 2u), o[0], o[1]);
                        else { const float lg = __builtin_amdgcn_logf(1.0f - __builtin_amdgcn_exp2f(-5.0f - (float)head));
                            const float w = RET_KSCALE * __builtin_amdgcn_exp2f((float)(127 - (row & 127)) * lg);
                            st8bf(at(RK, (unsigned)(row * 512 + head * 128 + cw) * 2u), o[0] * w, o[1] * w); } }
                } else if (pn < 8) {
#pragma unroll
                    for (int bj = 0; bj < 2; ++bj) st8bf(at(RV, (unsigned)(row * 512 + (pn & 1) * 256 + bj * 128 + cw) * 2u), acc[ai][bj][m][0], acc[ai][bj][m][1]);
                } else {
#pragma unroll
                    for (int bj = 0; bj < 2; ++bj) { f32x4 a = acc[ai][bj][m][0], b = acc[ai][bj][m][1];
#pragma unroll
                        for (int e = 0; e < 4; ++e) { a[e] = silu_f(a[e]); b[e] = silu_f(b[e]); }
                        st8bf(at(RG, (unsigned)(row * 512 + (pn & 1) * 256 + bj * 128 + cw) * 2u), a, b); }
                }
            }
    }
};

struct EpiUp {
    bf16* QKV; const float* SSQL; const float* CS;
    __device__ __forceinline__ void operator()(const Acc& acc, const pg8::Unit& u, int wr, int wc, int fr, int fq) const {
        const bool isq = u.pn < 3;
#pragma unroll
        for (int ai = 0; ai < 2; ++ai)
#pragma unroll
            for (int m = 0; m < 4; ++m) {
                const int row = u.pm * 256 + ai * 128 + wr * 64 + m * 16 + fr;
                const f32x4 sq = *(const f32x4*)at(SSQL, (unsigned)(row * 8 + (isq ? 0 : 4)) * 4u);
                const float inv = 1.0f / sqrtf(((sq[0] + sq[1]) + (sq[2] + sq[3])) * (isq ? 1.0f / 256.0f : 1.0f / 128.0f) + EPS);
                const float sc = isq ? inv * C2_MLA : inv;
                const float* cs = at(CS, (unsigned)row * 512u);
#pragma unroll
                for (int bj = 0; bj < 2; ++bj) { const int col = u.pn * 256 + bj * 128 + 32 * wc + 8 * fq; f32x4 o[2];
#pragma unroll
                    for (int n = 0; n < 2; ++n) { o[n] = acc[ai][bj][m][n] * sc; const int hc = (col + 4 * n) % 96;
                        if (isq && hc >= 64) { const int i0 = (hc - 64) >> 1; const f32x2 a = *(const f32x2*)(cs + 8 * i0), b = *(const f32x2*)(cs + 8 * i0 + 8); o[n] = rot2(o[n], (f32x4){a[0], a[1], b[0], b[1]}); } }
                    st8bf(at(QKV, (unsigned)(row * NUP + col) * 2u), o[0], o[1]); }
                asm volatile("" ::: "memory");
            }
    }
};

struct EpiStore {
    bf16* O; int ldc; const float* SSQ16; float scale;
    __device__ __forceinline__ void operator()(const Acc& acc, const pg8::Unit& u, int wr, int wc, int fr, int fq) const {
#pragma unroll
        for (int ai = 0; ai < 2; ++ai)
#pragma unroll
            for (int m = 0; m < 4; ++m) {
                const int row = u.pm * 256 + ai * 128 + wr * 64 + m * 16 + fr;
                float sc = scale;
                if (SSQ16) { const f32x4* p = (const f32x4*)at(SSQ16, (unsigned)row * 64u); const f32x4 a = p[0], b = p[1], c = p[2], d = p[3];
                    const float t = ((a[0] + a[1]) + (a[2] + a[3])) + ((b[0] + b[1]) + (b[2] + b[3])) + ((c[0] + c[1]) + (c[2] + c[3])) + ((d[0] + d[1]) + (d[2] + d[3]));
                    sc *= 1.0f / sqrtf(t * (1.0f / 1024.0f) + EPS); }
#pragma unroll
                for (int bj = 0; bj < 2; ++bj) st8bf(at(O, (unsigned)(row * ldc + u.pn * 256 + bj * 128 + 32 * wc + 8 * fq) * 2u), acc[ai][bj][m][0] * sc, acc[ai][bj][m][1] * sc);
            }
    }
};

struct EpiRes {
    const float* base; float* out; bf16* XB; float* SSQ16;
    __device__ __forceinline__ void operator()(const Acc& acc, const pg8::Unit& u, int wr, int wc, int fr, int fq) const {
#pragma unroll
        for (int ai = 0; ai < 2; ++ai)
#pragma unroll
            for (int m = 0; m < 4; ++m) {
                const int row = u.pm * 256 + ai * 128 + wr * 64 + m * 16 + fr; float s = 0.f;
#pragma unroll
                for (int bj = 0; bj < 2; ++bj) { const unsigned off = (unsigned)(row * D + u.pn * 256 + bj * 128 + 32 * wc + 8 * fq);
                    const f32x4 a = *(const f32x4*)at(base, off * 4u) + acc[ai][bj][m][0], b = *(const f32x4*)at(base, off * 4u + 16u) + acc[ai][bj][m][1];
                    *(f32x4*)at(out, off * 4u) = a; *(f32x4*)at(out, off * 4u + 16u) = b;
                    if (XB) st8bf(at(XB, off * 2u), a, b);
                    s += ssq8(a, b); }
                if (SSQ16) { s = red_fq(s); if (fq == 0) *at(SSQ16, (unsigned)(row * 16 + u.pn * 4 + wc) * 4u) = s; }
                if (m & 1) asm volatile("" ::: "memory");
            }
    }
};

struct EpiFfn {
    bf16* H; const float* SSQ16; const float* cw; const float* cb;
    __device__ __forceinline__ void operator()(const Acc& acc, const pg8::Unit& u, int wr, int wc, int fr, int fq) const {
        const int lane = threadIdx.x & 63;
        const int colh = u.pn * 128 + 32 * wc + 8 * fq;
        f32x4 w0[2], w1[2], w2[2], bb[2];
#pragma unroll
        for (int n = 0; n < 2; ++n) { w0[n] = *(const f32x4*)(cw + colh + 4 * n); w1[n] = *(const f32x4*)(cw + DFF + colh + 4 * n); w2[n] = *(const f32x4*)(cw + 2 * DFF + colh + 4 * n); bb[n] = *(const f32x4*)(cb + colh + 4 * n); }
        const int src1 = (lane & 48) | ((fr + 15) & 15), src2 = (lane & 48) | ((fr + 14) & 15);
#pragma unroll
        for (int ai = 0; ai < 2; ++ai) {
            const int row0 = u.pm * FF_TROWS + (2 * ai + wr) * FF_BLK - 2;
            f32x4 gp[2] = {(f32x4){0.f, 0.f, 0.f, 0.f}, (f32x4){0.f, 0.f, 0.f, 0.f}};
#pragma unroll
            for (int m = 0; m < 4; ++m) {
                const int t = row0 + m * 16 + fr;
                const int tc = t < 0 ? 0 : (t >= M ? M - 1 : t);
                const f32x4* p = (const f32x4*)at(SSQ16, (unsigned)tc * 64u); const f32x4 a = p[0], b = p[1], c = p[2], d = p[3];
                const float tt = ((a[0] + a[1]) + (a[2] + a[3])) + ((b[0] + b[1]) + (b[2] + b[3])) + ((c[0] + c[1]) + (c[2] + c[3])) + ((d[0] + d[1]) + (d[2] + d[3]));
                const float inv = 1.0f / sqrtf(tt * (1.0f / 1024.0f) + EPS);
                const int ts = t & (SEQ - 1);
                f32x4 o[2], gc[2];
#pragma unroll
                for (int n = 0; n < 2; ++n) {
                    gc[n] = acc[ai][0][m][n] * inv;
#pragma unroll
                    for (int e = 0; e < 4; ++e) {
                        const float cur = gc[n][e], prv = gp[n][e];
                        float g1 = __shfl(fr == 15 ? prv : cur, src1), g0 = __shfl(fr >= 14 ? prv : cur, src2);
                        if (ts < 1) g1 = 0.f; if (ts < 2) g0 = 0.f;
                        const float cv = bb[n][e] + w0[n][e] * g0 + w1[n][e] * g1 + w2[n][e] * cur;
                        o[n][e] = silu_f(cv) * (acc[ai][1][m][n][e] * inv);
                    }
                    gp[n] = gc[n];
                }
                if ((m > 0 || fr >= 2) && t < M) st8bf(at(H, (unsigned)(t * DFF + colh) * 2u), o[0], o[1]);
                asm volatile("" ::: "memory");
            }
        }
    }
};

#define XB_TMO      128
#define XB_XCNT(j)  (256  + 64 * (j))
#define XB_XSUB(j)  (1280 + 64 * (j))
#define XB_XGEN(j)  (2304 + 64 * (j))
#define XB_TOP      3328
#define XB_TOPGEN   3392
#define XCD_BAR_WORDS 3456
#define XB_SPIN_CAP (1u << 18)
__device__ __forceinline__ unsigned xb_ld(unsigned* p)              { return __hip_atomic_load(p, __ATOMIC_RELAXED, __HIP_MEMORY_SCOPE_AGENT); }
__device__ __forceinline__ unsigned xb_add(unsigned* p, unsigned v) { return __hip_atomic_fetch_add(p, v, __ATOMIC_RELAXED, __HIP_MEMORY_SCOPE_AGENT); }
__device__ __forceinline__ unsigned xb_xcc_id() { return (unsigned)__builtin_amdgcn_s_getreg((3 << 11) | 20) & 0xFu; }
#define XB_SPIN(cond, bar) do { unsigned _sp = 0; while (cond) { __builtin_amdgcn_s_sleep(1); \
    if ((++_sp & 255u) == 0u) { if (xb_ld(&(bar)[XB_TMO])) break; if (_sp > XB_SPIN_CAP) { atomicAdd(&(bar)[XB_TMO], 1u); break; } } } } while (0)
struct XcdBarrier { unsigned* bar; unsigned x; volatile LAS unsigned* st; };
__device__ __forceinline__ XcdBarrier xcd_barrier_post(unsigned* bar, volatile LAS unsigned* st) {
    XcdBarrier b; b.bar = bar; b.x = xb_xcc_id(); b.st = st;
    if (threadIdx.x == 0) (void)xb_add(&bar[XB_XCNT(b.x)], 1u);
    return b;
}
__device__ __forceinline__ void xcd_barrier_complete(unsigned* bar, unsigned x, unsigned& nloc, unsigned& nx) {
    const unsigned G = gridDim.x * gridDim.y * gridDim.z;
    unsigned sum, cnt, mine, sp = 0u;
    for (;;) {
        sum = 0u; cnt = 0u; mine = 0u;
#pragma unroll
        for (unsigned j = 0; j < 16; ++j) { const unsigned c = xb_ld(&bar[XB_XCNT(j)]); sum += c; cnt += (c > 0u) ? 1u : 0u; mine = (j == x) ? c : mine; }
        if (sum == G) break;
        __builtin_amdgcn_s_sleep(1);
        if ((++sp & 255u) == 0u) { if (xb_ld(&bar[XB_TMO])) break; if (sp > XB_SPIN_CAP) { atomicAdd(&bar[XB_TMO], 1u); break; } }
    }
    nloc = mine > 0u ? mine : 1u; nx = cnt > 0u ? cnt : 1u;
}
__device__ __forceinline__ void xcd_barrier(const XcdBarrier& b) {
    asm volatile("s_waitcnt vmcnt(0)" ::: "memory");
    __syncthreads();
    if (threadIdx.x == 0) {
        unsigned* bar = b.bar;
        __builtin_amdgcn_s_waitcnt(0);
        unsigned nloc = b.st[0], nx = b.st[1];
        if (nloc == 0u) { xcd_barrier_complete(bar, b.x, nloc, nx); b.st[0] = nloc; b.st[1] = nx; }
        const unsigned old = xb_add(&bar[XB_XSUB(b.x)], 1u);
        const unsigned gen = old / nloc;
        if (old + 1u == (gen + 1u) * nloc) {
            __builtin_amdgcn_fence(__ATOMIC_RELEASE, "agent");
            asm volatile("s_waitcnt vmcnt(0)" ::: "memory");
            const unsigned og = xb_add(&bar[XB_TOP], 1u);
            const unsigned tg = og / nx;
            if (og + 1u == (tg + 1u) * nx) xb_add(&bar[XB_TOPGEN], 1u);
            else XB_SPIN(xb_ld(&bar[XB_TOPGEN]) == tg, bar);
            __builtin_amdgcn_fence(__ATOMIC_ACQUIRE, "agent");
            xb_add(&bar[XB_XGEN(b.x)], 1u);
            asm volatile("s_waitcnt vmcnt(0)" ::: "memory");
        } else {
            XB_SPIN(xb_ld(&bar[XB_XGEN(b.x)]) == gen, bar);
            __builtin_amdgcn_fence(__ATOMIC_ACQUIRE, "agent");
            asm volatile("s_waitcnt vmcnt(0)" ::: "memory");
        }
    }
    __syncthreads();
}

constexpr int NWAVES = 8;
struct Frame {
    LAS unsigned char* lds; int tid, lane, wave, vcu, G;
};

__device__ __forceinline__ int map_proj(int n) {
    if (n < 384) return n;
    if (n < 416) { const int j = n - 384; return 384 + (j >> 1) + 16 * (j & 1); }
    if (n < 512) return -1;
    if (n < 1536) { const int j = n - 512, hd = j >> 7, c = j & 127; return 416 + hd * 128 + (c >> 1) + 64 * (c & 1); }
    return n - 1536 + 1440;
}
__device__ __forceinline__ int map_uq(int n) { const int h = n / 96, c = n % 96; if (c < 64) return n; const int j = c - 64; return h * 96 + 64 + (j >> 1) + 16 * (j & 1); }
__device__ __forceinline__ int map_ffi(int n) { const int t = n >> 8, c = n & 255; return (c < 128) ? t * 128 + c : DFF + t * 128 + (c - 128); }

template <int MAP>
__device__ __forceinline__ void transpose_item(const float* W, int K, int Nsrc, int Ndst, const float* g, bf16* WT, int ldk, int koff, int row_off, LAS float* scr, int item, int lane) {
    const int nblk = Ndst / 32, kb = item / nblk, nb = item % nblk, k0 = 64 * kb, n0 = 32 * nb;
    const int nd = n0 + (lane & 31);
    const int ns = MAP == 0 ? nd : (MAP == 1 ? map_proj(nd) : (MAP == 2 ? map_uq(nd) : map_ffi(nd)));
#pragma unroll 8
    for (int i = 0; i < 32; ++i) { const int kk = 2 * i + (lane >> 5); float v = 0.f; if (ns >= 0) { v = W[(size_t)(k0 + kk) * Nsrc + ns]; if (g) v *= g[k0 + kk]; } scr[kk * 33 + (lane & 31)] = v; }
    asm volatile("s_waitcnt lgkmcnt(0)" ::: "memory");
    const int c = lane & 7;
#pragma unroll
    for (int j = 0; j < 4; ++j) { const int n = (lane >> 3) + 8 * j; const LAS float* s = scr + (8 * c) * 33 + n;
        u32x4 o; o.x = cvt_pk(s[0 * 33], s[1 * 33]); o.y = cvt_pk(s[2 * 33], s[3 * 33]); o.z = cvt_pk(s[4 * 33], s[5 * 33]); o.w = cvt_pk(s[6 * 33], s[7 * 33]);
        *(u32x4*)(WT + (size_t)(row_off + n0 + n) * ldk + koff + k0 + 8 * c) = o; }
    asm volatile("s_waitcnt lgkmcnt(0)" ::: "memory");
}
__device__ __forceinline__ void rms_row_to_bf16(const float* xrow, const float* g, bf16* orow, int lane) {
    const f32x4* xr = (const f32x4*)xrow + lane;
    f32x4 v[4]; float s = 0.f;
#pragma unroll
    for (int j = 0; j < 4; ++j) { v[j] = xr[64 * j]; s += (v[j][0] * v[j][0] + v[j][1] * v[j][1]) + (v[j][2] * v[j][2] + v[j][3] * v[j][3]); }
    const float inv = 1.0f / sqrtf(wave_sum(s) * (1.0f / D) + EPS);
    u32x2* o8 = (u32x2*)orow + lane;
#pragma unroll
    for (int j = 0; j < 4; ++j) { f32x4 w = v[j] * inv; if (g) w = w * ((const f32x4*)g)[lane + 64 * j]; u32x2 t; t.x = cvt_pk(w[0], w[1]); t.y = cvt_pk(w[2], w[3]); o8[64 * j] = t; }
}

struct Ptrs {
    const float *x, *mem; const int* pos; const float *g_mix, *w_in, *g_q_lat, *w_uq, *g_kv_lat, *w_ukv, *w_out, *g_xattn, *g_mem, *w_xq, *w_xkv, *w_xo, *g_ffn, *w_ffn_in, *conv_w, *conv_b, *w_ffn_out, *g_final;
    float* out; unsigned char* ws;
};

__device__ __forceinline__ void p0_prologue(const Frame& F, const Ptrs& P) {
    LAS float* scr = (LAS float*)(F.lds + F.wave * 16384);
    const int gw = F.vcu * NWAVES + F.wave, NGW = F.G * NWAVES, lane = F.lane;
    unsigned char* ws = P.ws;
    bf16* Win = (bf16*)(ws + WS_WIN); bf16* Wup = (bf16*)(ws + WS_WUP);
    for (int i = gw * 64 + lane; i < 768 * 16 + 1024 * 32; i += NGW * 64) {
        if (i < 768 * 16) { const int r = i >> 4, c = i & 15; *(u32x4*)(Wup + (size_t)r * NLAT + 256 + 8 * c) = (u32x4){0u, 0u, 0u, 0u}; }
        else { const int j = i - 768 * 16, r = 768 + (j >> 5), c = j & 31; *(u32x4*)(Wup + (size_t)r * NLAT + 8 * c) = (u32x4){0u, 0u, 0u, 0u}; }
    }
    constexpr int I_IN = (D / 64) * (NPROJ / 32), I_UQ = (256 / 64) * (768 / 32), I_UKV = (128 / 64) * (1024 / 32), I_SQ = (D / 64) * (D / 32), I_XKV = (D / 64) * (2048 / 32), I_FFI = (D / 64) * (NFF / 32), I_FFO = (DFF / 64) * (D / 32);
    constexpr int NITEMS = I_IN + I_UQ + I_UKV + 3 * I_SQ + I_XKV + I_FFI + I_FFO;
    for (int it = gw; it < NITEMS; it += NGW) {
        int r = it;
        if (r < I_IN) { transpose_item<1>(P.w_in, D, 2464, NPROJ, P.g_mix, Win, D, 0, 0, scr, r, lane); continue; } r -= I_IN;
        if (r < I_UQ) { transpose_item<2>(P.w_uq, 256, 768, 768, P.g_q_lat, Wup, NLAT, 0, 0, scr, r, lane); continue; } r -= I_UQ;
        if (r < I_UKV) { transpose_item<0>(P.w_ukv, 128, 1024, 1024, P.g_kv_lat, Wup, NLAT, 256, 768, scr, r, lane); continue; } r -= I_UKV;
        if (r < I_SQ) { transpose_item<0>(P.w_out, D, D, D, nullptr, (bf16*)(ws + WS_WOUT), D, 0, 0, scr, r, lane); continue; } r -= I_SQ;
        if (r < I_SQ) { transpose_item<0>(P.w_xq, D, D, D, P.g_xattn, (bf16*)(ws + WS_WXQ), D, 0, 0, scr, r, lane); continue; } r -= I_SQ;
        if (r < I_SQ) { transpose_item<0>(P.w_xo, D, D, D, nullptr, (bf16*)(ws + WS_WXO), D, 0, 0, scr, r, lane); continue; } r -= I_SQ;
        if (r < I_XKV) { transpose_item<0>(P.w_xkv, D, 2048, 2048, nullptr, (bf16*)(ws + WS_WXKV), D, 0, 0, scr, r, lane); continue; } r -= I_XKV;
        if (r < I_FFI) { transpose_item<3>(P.w_ffn_in, D, NFF, NFF, P.g_ffn, (bf16*)(ws + WS_WFFI), D, 0, 0, scr, r, lane); continue; } r -= I_FFI;
        transpose_item<0>(P.w_ffn_out, DFF, D, D, nullptr, (bf16*)(ws + WS_WFFO), DFF, 0, 0, scr, r, lane);
    }
    bf16* XN = (bf16*)(ws + WS_A); bf16* MEMN = (bf16*)(ws + WS_MEMN); float* CS = (float*)(ws + WS_CS);
    for (int m = gw; m < M + NB * 256; m += NGW) {
        if (m < M) rms_row_to_bf16(P.x + (size_t)m * D, nullptr, XN + (size_t)m * D, lane);
        else rms_row_to_bf16(P.mem + (size_t)(m - M) * D, P.g_mem, MEMN + (size_t)(m - M) * D, lane);
    }
    for (int m = gw; m < M; m += NGW) {
        const float inv_freq = exp2f(-(float)lane * (13.287712379549449f / 64.0f));
        const float ang = (float)P.pos[m] * inv_freq;
        *(f32x2*)(CS + (size_t)m * 128 + 2 * lane) = (f32x2){cosf(ang), sinf(ang)};
    }
}

template <int NDT, int VP>
__device__ __forceinline__ void flash_step(f32x16& X0, f32x16& X1, f32x16 (&O)[NDT], float& mrun, float& lrun, const LAS unsigned char* vbase, LAS float* wsf, int lane) {
    const int hi = lane >> 5;
    float rm = X0[0];
#pragma unroll
    for (int r = 1; r < 16; ++r) rm = fmaxf(rm, X0[r]);
#pragma unroll
    for (int r = 0; r < 16; ++r) rm = fmaxf(rm, X1[r]);
    rm = fmaxf(rm, __shfl_xor(rm, 32));
    const float mnew = fmaxf(mrun, rm);
    const float alpha = __builtin_amdgcn_exp2f(mrun - mnew);
    mrun = mnew;
    float ps = 0.f;
#pragma unroll
    for (int r = 0; r < 16; ++r) { X0[r] = __builtin_amdgcn_exp2f(X0[r] - mnew); X1[r] = __builtin_amdgcn_exp2f(X1[r] - mnew); ps += X0[r] + X1[r]; }
    lrun = lrun * alpha + ps;
    if (__any(alpha != 1.0f)) {
        if (hi == 0) wsf[lane] = alpha;
        asm volatile("s_waitcnt lgkmcnt(0)" ::: "memory");
#pragma unroll
        for (int r = 0; r < 16; ++r) { const float a = wsf[crow(r, hi)];
#pragma unroll
            for (int dt = 0; dt < NDT; ++dt) O[dt][r] *= a; }
        asm volatile("s_waitcnt lgkmcnt(0)" ::: "memory");
    }
    const bf16x8 pa0 = pack8(X0[0], X0[1], X0[2], X0[3], X0[4], X0[5], X0[6], X0[7]), pa1 = pack8(X0[8], X0[9], X0[10], X0[11], X0[12], X0[13], X0[14], X0[15]);
    const bf16x8 pa2 = pack8(X1[0], X1[1], X1[2], X1[3], X1[4], X1[5], X1[6], X1[7]), pa3 = pack8(X1[8], X1[9], X1[10], X1[11], X1[12], X1[13], X1[14], X1[15]);
    const LAS unsigned char* vl = vbase + (4 * hi + ((lane & 15) >> 2)) * VP + (16 * ((lane >> 4) & 1) + 4 * (lane & 3)) * 2;
#pragma unroll
    for (int dt = 0; dt < NDT; ++dt) {
        const bf16x8 v0 = tr_frag(vl + 0 * 16 * VP + dt * 64, vl + (0 * 16 + 8) * VP + dt * 64);
        const bf16x8 v1 = tr_frag(vl + 1 * 16 * VP + dt * 64, vl + (1 * 16 + 8) * VP + dt * 64);
        const bf16x8 v2 = tr_frag(vl + 2 * 16 * VP + dt * 64, vl + (2 * 16 + 8) * VP + dt * 64);
        const bf16x8 v3 = tr_frag(vl + 3 * 16 * VP + dt * 64, vl + (3 * 16 + 8) * VP + dt * 64);
        O[dt] = MFMA32(pa0, v0, O[dt]); O[dt] = MFMA32(pa1, v1, O[dt]); O[dt] = MFMA32(pa2, v2, O[dt]); O[dt] = MFMA32(pa3, v3, O[dt]);
    }
}
template <int NDT>
__device__ __forceinline__ void flash_store(f32x16 (&O)[NDT], float lrun, LAS float* wsf, int lane, bf16* out, size_t ldo) {
    const int hi = lane >> 5;
    lrun += __shfl_xor(lrun, 32);
    if (hi == 0) wsf[lane] = 1.0f / lrun;
    asm volatile("s_waitcnt lgkmcnt(0)" ::: "memory");
#pragma unroll
    for (int r = 0; r < 16; ++r) { const float a = wsf[crow(r, hi)];
#pragma unroll
        for (int dt = 0; dt < NDT; ++dt) { const unsigned w = cvt_pk(O[dt][r] * a, 0.f); *at(out, (unsigned)(crow(r, hi) * (int)ldo + 32 * dt + (lane & 31)) * 2u) = (bf16)(w & 0xffffu); } }
    asm volatile("s_waitcnt lgkmcnt(0)" ::: "memory");
}

constexpr int MLA_KSLOT = 12288, MLA_VSLOT = 8192, MLA_K0 = 0, MLA_V0 = 3 * MLA_KSLOT, MLA_WS = MLA_V0 + 3 * MLA_VSLOT, MLA_OST = MLA_WS + 8 * 128, MLA_LDS = MLA_OST + 8 * 4096;
static_assert(MLA_LDS <= RING_BYTES, "MLA LDS");
__device__ __forceinline__ void glds16(const void* gsrc, unsigned lds_dst) { unsigned keep;
    asm volatile("s_mov_b32 %0, m0\n\ts_mov_b32 m0, %2\n\ts_nop 0\n\tglobal_load_lds_dwordx4 %1, off\n\ts_mov_b32 m0, %0" : "=&s"(keep) : "v"(gsrc), "s"(lds_dst) : "memory"); }
#define MLA_WAIT_BAR(N) asm volatile("s_waitcnt vmcnt(" #N ") lgkmcnt(0)\n\ts_barrier" ::: "memory")
__device__ __forceinline__ void mla_unit(const Frame& F, int b, int h, int qb, const bf16* QKV, const bf16* KR, bf16* Y) {
    int tid = F.tid; asm volatile("" : "+v"(tid));
    const int lane = tid & 63, wid = F.wave, r32 = lane & 31, hi = lane >> 5;
    const LAS unsigned char* lds = F.lds;
    const unsigned lds0 = (unsigned)(uintptr_t)F.lds;
    LAS float* wsf = (LAS float*)(F.lds + MLA_WS) + wid * 32;
    const size_t rb = (size_t)b * SEQ; const int q0 = qb * 256;
    const int qrow = q0 + 32 * wid + r32;
    const int NT = (q0 + 256) / 64;
    const int tmax = q0 / 64 + (wid >> 1);
    const bf16* ksrc = at(QKV + rb * NUP + 768 + h * 128 + wid * 8, (unsigned)(lane * NUP) * 2u);
    const bf16* rsrc = at(KR + rb * 32 + (wid & 3) * 8, (unsigned)(lane * 32) * 2u);
    const bf16* vsrc = at(QKV + rb * NUP + 768 + h * 128 + 64 + (wid >> 2) * 32, (unsigned)((16 * (wid & 3) + (lane >> 2)) * NUP + (lane & 3) * 8) * 2u);
    const unsigned kdst = lds0 + MLA_K0 + wid * 1024, rdst = lds0 + MLA_K0 + (8 + (wid & 3)) * 1024, vdst = lds0 + MLA_V0 + wid * 1024;
#define MLA_DMA(t, slot) do { glds16(ksrc + (size_t)(t) * 64 * NUP, (unsigned)__builtin_amdgcn_readfirstlane(kdst + (slot) * MLA_KSLOT)); \
        glds16(rsrc + (size_t)(t) * 64 * 32, (unsigned)__builtin_amdgcn_readfirstlane(rdst + (slot) * MLA_KSLOT)); \
        glds16(vsrc + (size_t)(t) * 64 * NUP, (unsigned)__builtin_amdgcn_readfirstlane(vdst + (slot) * MLA_VSLOT)); } while (0)
    MLA_DMA(0, 0); MLA_DMA(1, 1);
    bf16x8 qf[6];
#pragma unroll
    for (int s = 0; s < 6; ++s) qf[s] = *(const bf16x8*)at(QKV + (rb + q0 + 32 * wid) * NUP + h * 96, (unsigned)(r32 * NUP + 16 * s + 8 * hi) * 2u);
    float mrun = -1e30f, lrun = 0.f; f32x16 O[2]; O[0] = (f32x16){}; O[1] = (f32x16){};
    const int koff = hi * 1024 + r32 * 16;
    const int voff = (4 * hi + ((lane & 15) >> 2)) * 64 + (16 * ((lane >> 4) & 1) + 4 * (lane & 3)) * 2;
    int slot = 0;
    for (int t = 0; t < NT; ++t) {
        if (t + 1 < NT) MLA_WAIT_BAR(3); else MLA_WAIT_BAR(0);
        if (t + 2 < NT) { const int s2 = slot == 0 ? 2 : slot - 1; MLA_DMA(t + 2, s2); }
        if (t <= tmax) {
            const LAS unsigned char* kt = lds + MLA_K0 + slot * MLA_KSLOT + koff;
            f32x16 X0 = (f32x16){}, X1 = (f32x16){};
#pragma unroll
            for (int s = 0; s < 6; ++s) { const bf16x8 k0 = *(const LAS bf16x8*)(kt + s * 2048), k1 = *(const LAS bf16x8*)(kt + s * 2048 + 512); X0 = MFMA32(k0, qf[s], X0); X1 = MFMA32(k1, qf[s], X1); }
            if (64 * t + 63 > q0 + 32 * wid) {
#pragma unroll
                for (int r = 0; r < 16; ++r) { const int kk = 64 * t + crow(r, hi); if (kk > qrow) X0[r] = -INFINITY; if (kk + 32 > qrow) X1[r] = -INFINITY; }
            }
            float rm = X0[0];
#pragma unroll
            for (int r = 1; r < 16; ++r) rm = fmaxf(rm, X0[r]);
#pragma unroll
            for (int r = 0; r < 16; ++r) rm = fmaxf(rm, X1[r]);
            rm = fmaxf(rm, __shfl_xor(rm, 32));
            if (__any(rm > mrun + 8.0f)) {
                const float mnew = fmaxf(mrun, rm), alpha = __builtin_amdgcn_exp2f(mrun - mnew);
                mrun = mnew; lrun *= alpha;
                if (hi == 0) wsf[lane] = alpha;
                asm volatile("s_waitcnt lgkmcnt(0)" ::: "memory");
#pragma unroll
                for (int r = 0; r < 16; ++r) { const float a = wsf[crow(r, hi)]; O[0][r] *= a; O[1][r] *= a; }
                asm volatile("s_waitcnt lgkmcnt(0)" ::: "memory");
            }
            float ps = 0.f;
#pragma unroll
            for (int r = 0; r < 16; ++r) { X0[r] = __builtin_amdgcn_exp2f(X0[r] - mrun); X1[r] = __builtin_amdgcn_exp2f(X1[r] - mrun); ps += X0[r] + X1[r]; }
            lrun += ps;
            const bf16x8 pa0 = pack8(X0[0], X0[1], X0[2], X0[3], X0[4], X0[5], X0[6], X0[7]), pa1 = pack8(X0[8], X0[9], X0[10], X0[11], X0[12], X0[13], X0[14], X0[15]);
            const bf16x8 pa2 = pack8(X1[0], X1[1], X1[2], X1[3], X1[4], X1[5], X1[6], X1[7]), pa3 = pack8(X1[8], X1[9], X1[10], X1[11], X1[12], X1[13], X1[14], X1[15]);
            const LAS unsigned char* vl = lds + MLA_V0 + slot * MLA_VSLOT + voff;
#pragma unroll
            for (int dt = 0; dt < 2; ++dt) {
                const bf16x8 v0 = tr_frag(vl + (dt * 4 + 0) * 1024, vl + (dt * 4 + 0) * 1024 + 512), v1 = tr_frag(vl + (dt * 4 + 1) * 1024, vl + (dt * 4 + 1) * 1024 + 512);
                const bf16x8 v2 = tr_frag(vl + (dt * 4 + 2) * 1024, vl + (dt * 4 + 2) * 1024 + 512), v3 = tr_frag(vl + (dt * 4 + 3) * 1024, vl + (dt * 4 + 3) * 1024 + 512);
                O[dt] = MFMA32(pa0, v0, O[dt]); O[dt] = MFMA32(pa1, v1, O[dt]); O[dt] = MFMA32(pa2, v2, O[dt]); O[dt] = MFMA32(pa3, v3, O[dt]);
            }
        }
        slot = slot == 2 ? 0 : slot + 1;
    }
    lrun += __shfl_xor(lrun, 32);
    if (hi == 0) wsf[lane] = 1.0f / lrun;
    asm volatile("s_waitcnt lgkmcnt(0)" ::: "memory");
    LAS bf16* stg = (LAS bf16*)(F.lds + MLA_OST) + wid * 2048;
#pragma unroll
    for (int r = 0; r < 16; ++r) { const float a = wsf[crow(r, hi)]; const int orow = crow(r, hi);
        stg[orow * 64 + r32] = (bf16)(cvt_pk(O[0][r] * a, 0.f) & 0xffffu); stg[orow * 64 + 32 + r32] = (bf16)(cvt_pk(O[1][r] * a, 0.f) & 0xffffu); }
    asm volatile("s_waitcnt lgkmcnt(0)" ::: "memory");
    bf16* Yw = Y + (rb + q0 + 32 * wid) * D + h * 64;
#pragma unroll
    for (int i = 0; i < 4; ++i) { const int row = i * 8 + (lane >> 3), ch = lane & 7; const u32x4 v = *(const LAS u32x4*)(stg + row * 64 + ch * 8); *(u32x4*)at(Yw, (unsigned)(row * D + ch * 8) * 2u) = v; }
    asm volatile("s_waitcnt lgkmcnt(0)\n\ts_barrier" ::: "memory");
#undef MLA_DMA
}

constexpr int XA_VP = 320;
__device__ __forceinline__ void xattn_unit(const Frame& F, int pm, int h, const bf16* QX, const bf16* MKV, bf16* OX) {
    int tid = F.tid; asm volatile("" : "+v"(tid));
    const int lane = tid & 63, wid = F.wave, r32 = lane & 31, hi = lane >> 5;
    LAS unsigned char* vt = F.lds;
    LAS float* wsf = (LAS float*)(F.lds + 256 * XA_VP) + wid * 32;
    const int b = pm >> 4;
    const size_t row0 = (size_t)pm * 256 + 32 * wid;
    const bf16* qp = at(QX + row0 * D + h * 256, (unsigned)(r32 * D + 8 * hi) * 2u);
    const bf16* kbase = MKV + (size_t)b * 256 * 2048 + h * 256;
#pragma unroll 1
    for (int dh = 0; dh < 2; ++dh) {
#pragma unroll
        for (int i = 0; i < 8; ++i) { const int p = tid + 512 * i, key = p >> 4, ch = p & 15;
            *(LAS u32x4*)(vt + key * XA_VP + ch * 16) = *(const u32x4*)at(kbase + 1024 + dh * 128, (unsigned)(key * 2048 + ch * 8) * 2u); }
        __syncthreads();
        float mrun = -1e30f, lrun = 0.f; f32x16 O[4]; O[0] = (f32x16){}; O[1] = (f32x16){}; O[2] = (f32x16){}; O[3] = (f32x16){};
#pragma unroll 1
        for (int t = 0; t < 4; ++t) {
            f32x16 X0 = (f32x16){}, X1 = (f32x16){};
            const bf16* kp = at(kbase + (size_t)(64 * t) * 2048, (unsigned)(r32 * 2048 + 8 * hi) * 2u);
            const bf16* kp1 = at(kbase + (size_t)(64 * t + 32) * 2048, (unsigned)(r32 * 2048 + 8 * hi) * 2u);
#pragma unroll
            for (int s = 0; s < 16; ++s) { const bf16x8 q = *(const bf16x8*)(qp + 16 * s), k0 = *(const bf16x8*)(kp + 16 * s), k1 = *(const bf16x8*)(kp1 + 16 * s); X0 = MFMA32(k0, q, X0); X1 = MFMA32(k1, q, X1);
                if ((s & 3) == 3) __builtin_amdgcn_sched_barrier(0); }
            flash_step<4, XA_VP>(X0, X1, O, mrun, lrun, vt + 64 * t * XA_VP, wsf, lane);
        }
        flash_store<4>(O, lrun, wsf, lane, OX + row0 * D + h * 256 + dh * 128, D);
        __syncthreads();
    }
}

constexpr int RT_VP = 320;
__device__ __forceinline__ void stage_tile128(LAS unsigned char* dst, const bf16* src, size_t ld, int tid) {
#pragma unroll
    for (int i = 0; i < 4; ++i) { const int p = tid + 512 * i, row = p >> 4, ch = p & 15; *(LAS u32x4*)(dst + row * RT_VP + ch * 16) = *(const u32x4*)at(src, (unsigned)(row * (int)ld + ch * 8) * 2u); }
}
__device__ __forceinline__ void ret_kv_unit(const Frame& F, int U, const bf16* RK, const bf16* RV, float* KVT) {
    int tid = F.tid; asm volatile("" : "+v"(tid));
    const int lane = tid & 63, wid = F.wave, hi = lane >> 5;
    const int bh = U >> 5, c = U & 31, b = bh >> 2, h = bh & 3;
    const size_t t0 = (size_t)b * SEQ + c * 128;
    LAS unsigned char* kt = F.lds; LAS unsigned char* vt = F.lds + 128 * RT_VP;
    stage_tile128(kt, RK + t0 * 512 + h * 128, 512, tid); stage_tile128(vt, RV + t0 * 512 + h * 128, 512, tid);
    __syncthreads();
    const int dvb = wid >> 1, dk0 = 2 * (wid & 1);
    f32x16 acc0 = (f32x16){}, acc1 = (f32x16){};
    const int lo = (8 * hi + ((lane & 15) >> 2)) * RT_VP + (16 * ((lane >> 4) & 1) + 4 * (lane & 3)) * 2;
#pragma unroll
    for (int s = 0; s < 8; ++s) {
        const bf16x8 af = tr_frag(vt + lo + 16 * s * RT_VP + dvb * 64, vt + lo + (16 * s + 4) * RT_VP + dvb * 64);
        const bf16x8 b0 = tr_frag(kt + lo + 16 * s * RT_VP + dk0 * 64, kt + lo + (16 * s + 4) * RT_VP + dk0 * 64);
        const bf16x8 b1 = tr_frag(kt + lo + 16 * s * RT_VP + (dk0 + 1) * 64, kt + lo + (16 * s + 4) * RT_VP + (dk0 + 1) * 64);
        acc0 = MFMA32(af, b0, acc0); acc1 = MFMA32(af, b1, acc1);
    }
    float* o = KVT + (size_t)U * 16384 + (size_t)(32 * dvb) * 128 + 32 * dk0;
#pragma unroll
    for (int r = 0; r < 16; ++r) { *at(o, (unsigned)(crow(r, hi) * 128 + (lane & 31)) * 4u) = acc0[r]; *at(o, (unsigned)(crow(r, hi) * 128 + 32 + (lane & 31)) * 4u) = acc1[r]; }
    __syncthreads();
}
__device__ __forceinline__ void ret_scan(const Frame& F, float* KVT) {
    const int gt = F.vcu * 512 + F.tid, NT = F.G * 512;
    for (int i = gt; i < 16 * 16384; i += NT) {
        const int bh = i >> 14, e = i & 16383, h = bh & 3;
        const float lg = __builtin_amdgcn_logf(1.0f - __builtin_amdgcn_exp2f(-5.0f - (float)h));
        const float dec = __builtin_amdgcn_exp2f(128.0f * lg);
        const unsigned po = (unsigned)(bh * 32 * 16384 + e) * 4u; float st = 0.f;
#pragma unroll 8
        for (int c = 0; c < 32; ++c) { float* p = at(KVT, po + (unsigned)c * 65536u); const float v = *p; *p = st; st = dec * st + v; }
    }
}
__device__ __forceinline__ void ret_out_pair(const Frame& F, int pair, const bf16* RQ, const bf16* RK, const bf16* RV, const bf16* RG, const float* KVT, bf16* Y) {
    int tid = F.tid; asm volatile("" : "+v"(tid));
    const int lane = tid & 63, wid = F.wave, r32 = lane & 31, hi = lane >> 5;
    const int u = wid >> 2, ib = wid & 3, U = 2 * pair + u;
    const int bh = U >> 5, c = U & 31, b = bh >> 2, h = bh & 3;
    const size_t t0 = (size_t)b * SEQ + c * 128;
    {
        const int U0 = 2 * pair, bh0 = U0 >> 5, c0 = U0 & 31; const size_t s0 = (size_t)(bh0 >> 2) * SEQ + c0 * 128;
        stage_tile128(F.lds, RV + s0 * 512 + (bh0 & 3) * 128, 512, tid);
        const int U1 = U0 + 1, bh1 = U1 >> 5, c1 = U1 & 31; const size_t s1 = (size_t)(bh1 >> 2) * SEQ + c1 * 128;
        stage_tile128(F.lds + 128 * RT_VP, RV + s1 * 512 + (bh1 & 3) * 128, 512, tid);
    }
    __syncthreads();
    const LAS unsigned char* vt = F.lds + u * 128 * RT_VP;
    const float lg = __builtin_amdgcn_logf(1.0f - __builtin_amdgcn_exp2f(-5.0f - (float)h));
    bf16x8 qf[8];
#pragma unroll
    for (int s = 0; s < 8; ++s) qf[s] = *(const bf16x8*)at(RQ + (t0 + 32 * ib) * 512 + h * 128, (unsigned)(r32 * 512 + 16 * s + 8 * hi) * 2u);
    f32x16 acc[4]; acc[0] = (f32x16){}; acc[1] = (f32x16){}; acc[2] = (f32x16){}; acc[3] = (f32x16){};
    if (c > 0) {
        const float* pv = at(KVT + (size_t)U * 16384, (unsigned)(r32 * 128 + 8 * hi) * 4u);
#pragma unroll
        for (int s = 0; s < 8; ++s)
#pragma unroll
            for (int dt = 0; dt < 4; ++dt) { const f32x4 a = *(const f32x4*)(pv + (size_t)dt * 32 * 128 + 16 * s), bq = *(const f32x4*)(pv + (size_t)dt * 32 * 128 + 16 * s + 4);
                acc[dt] = MFMA32(qf[s], pack8(a[0], a[1], a[2], a[3], bq[0], bq[1], bq[2], bq[3]), acc[dt]); }
#pragma unroll
        for (int r = 0; r < 16; ++r) { const float sc = __builtin_amdgcn_exp2f((float)(32 * ib + crow(r, hi) + 1) * lg);
#pragma unroll
            for (int dt = 0; dt < 4; ++dt) acc[dt][r] *= sc; }
    }
    const float colsc = __builtin_amdgcn_exp2f((float)(32 * ib + r32 - 127) * lg);
    const int vlo = (4 * hi + ((lane & 15) >> 2)) * RT_VP + (16 * ((lane >> 4) & 1) + 4 * (lane & 3)) * 2;
#pragma unroll 1
    for (int jb = 0; jb <= ib; ++jb) {
        f32x16 X = (f32x16){};
        const bf16* kp = at(RK + (t0 + 32 * jb) * 512 + h * 128, (unsigned)(r32 * 512 + 8 * hi) * 2u);
#pragma unroll
        for (int s = 0; s < 8; ++s) X = MFMA32(*(const bf16x8*)(kp + 16 * s), qf[s], X);
#pragma unroll
        for (int r = 0; r < 16; ++r) { X[r] *= colsc; if (jb == ib && crow(r, hi) > r32) X[r] = 0.f; }
        const bf16x8 pa0 = pack8(X[0], X[1], X[2], X[3], X[4], X[5], X[6], X[7]), pa1 = pack8(X[8], X[9], X[10], X[11], X[12], X[13], X[14], X[15]);
        const LAS unsigned char* vb = vt + vlo + 32 * jb * RT_VP;
#pragma unroll
        for (int dt = 0; dt < 4; ++dt) {
            const bf16x8 v0 = tr_frag(vb + dt * 64, vb + 8 * RT_VP + dt * 64), v1 = tr_frag(vb + 16 * RT_VP + dt * 64, vb + 24 * RT_VP + dt * 64);
            acc[dt] = MFMA32(pa0, v0, acc[dt]); acc[dt] = MFMA32(pa1, v1, acc[dt]);
        }
    }
#pragma unroll
    for (int r = 0; r < 16; ++r) {
        float s1 = (acc[0][r] + acc[1][r]) + (acc[2][r] + acc[3][r]);
        float s2 = (acc[0][r] * acc[0][r] + acc[1][r] * acc[1][r]) + (acc[2][r] * acc[2][r] + acc[3][r] * acc[3][r]);
#pragma unroll
        for (int o = 1; o < 32; o <<= 1) { s1 += __shfl_xor(s1, o); s2 += __shfl_xor(s2, o); }
        const float mean = s1 * (1.0f / 128.0f), var = fmaxf(s2 * (1.0f / 128.0f) - mean * mean, 0.f), rstd = 1.0f / sqrtf(var + EPS);
        const int rl = crow(r, hi);
#pragma unroll
        for (int dt = 0; dt < 4; ++dt) { const float g = bf2f(*at(RG + (t0 + 32 * ib) * 512 + h * 128, (unsigned)(rl * 512 + 32 * dt + r32) * 2u));
            const unsigned w = cvt_pk((acc[dt][r] - mean) * rstd * g, 0.f); *at(Y + (t0 + 32 * ib) * D + 512 + h * 128, (unsigned)(rl * D + 32 * dt + r32) * 2u) = (bf16)(w & 0xffffu); }
    }
    __syncthreads();
}

constexpr int N_PHASES = 12;
struct Args { const void* in[21]; float* out; unsigned char* ws; int ph_lo, ph_hi, flags, li; };
__global__ void __launch_bounds__(NWAVES * 64, 2) hymba_fwd(Args args) {
    extern __shared__ __attribute__((aligned(16))) unsigned char lds_raw[];
    Frame F;
    F.lds = (LAS unsigned char*)lds_raw;
    F.tid = threadIdx.x; F.lane = F.tid & 63; F.wave = __builtin_amdgcn_readfirstlane(F.tid >> 6);
    F.G = gridDim.x; { const int bx = blockIdx.x; F.vcu = (F.G % 8 == 0) ? (bx % 8) * (F.G / 8) + bx / 8 : bx; }
    Ptrs P;
    P.x = (const float*)args.in[0]; P.mem = (const float*)args.in[1]; P.pos = (const int*)args.in[2]; P.g_mix = (const float*)args.in[3]; P.w_in = (const float*)args.in[4];
    P.g_q_lat = (const float*)args.in[5]; P.w_uq = (const float*)args.in[6]; P.g_kv_lat = (const float*)args.in[7]; P.w_ukv = (const float*)args.in[8]; P.w_out = (const float*)args.in[9];
    P.g_xattn = (const float*)args.in[10]; P.g_mem = (const float*)args.in[11]; P.w_xq = (const float*)args.in[12]; P.w_xkv = (const float*)args.in[13]; P.w_xo = (const float*)args.in[14];
    P.g_ffn = (const float*)args.in[15]; P.w_ffn_in = (const float*)args.in[16]; P.conv_w = (const float*)args.in[17]; P.conv_b = (const float*)args.in[18]; P.w_ffn_out = (const float*)args.in[19];
    P.g_final = (const float*)args.in[20]; P.out = args.out; P.ws = args.ws;
    unsigned char* ws = args.ws;
    gu32* ctl = (gu32*)(ws + WS_CTL);
    volatile LAS unsigned* MISC = (volatile LAS unsigned*)(F.lds + MISC_OFF);
    for (int u = F.tid; u < (LDS_BYTES - LDSCTL_OFF) / 4; u += NWAVES * 64) ((LAS unsigned*)(F.lds + LDSCTL_OFF))[u] = 0u;
    __syncthreads();
    XcdBarrier bar; bar.bar = (unsigned*)(ctl + CW_BAR) + args.li * XCD_BAR_WORDS; bar.x = 0; bar.st = nullptr;
    if (MK_N_LAUNCHES == 1) bar = xcd_barrier_post((unsigned*)(ctl + CW_BAR) + args.li * XCD_BAR_WORDS, MISC + 8);
    const int lo = args.ph_lo, hi_ph = args.ph_hi;
#ifndef PH_MASK
#define PH_MASK 0xFFF
#endif
#define IN(k) ((((PH_MASK) >> (k)) & 1) && lo <= (k) && (k) < hi_ph)
#define SEAM(k) do { if (IN(k) && IN((k) + 1)) xcd_barrier(bar); } while (0)

    bf16* Win = (bf16*)(ws + WS_WIN); bf16* Wup = (bf16*)(ws + WS_WUP); bf16* Wout = (bf16*)(ws + WS_WOUT); bf16* Wxq = (bf16*)(ws + WS_WXQ); bf16* Wxkv = (bf16*)(ws + WS_WXKV);
    bf16* Wxo = (bf16*)(ws + WS_WXO); bf16* Wffi = (bf16*)(ws + WS_WFFI); bf16* Wffo = (bf16*)(ws + WS_WFFO);
    float* CS = (float*)(ws + WS_CS); float* SSQL = (float*)(ws + WS_SSQL); float* SSQ1 = (float*)(ws + WS_SSQ1); float* SSQ2 = (float*)(ws + WS_SSQ2);
    bf16* MEMN = (bf16*)(ws + WS_MEMN); bf16* MKV = (bf16*)(ws + WS_MKV);
    bf16* XN = (bf16*)(ws + WS_A); bf16* Y = (bf16*)(ws + WS_A); bf16* XB2 = (bf16*)(ws + WS_A);
    bf16* LAT = (bf16*)(ws + WS_LAT); bf16* KR = (bf16*)(ws + WS_KR); bf16* RQ = (bf16*)(ws + WS_RQ); bf16* RK = (bf16*)(ws + WS_RK); bf16* RV = (bf16*)(ws + WS_RV); bf16* RG = (bf16*)(ws + WS_RG);
    bf16* QKV = (bf16*)(ws + WS_C); float* KVT = (float*)(ws + WS_KVT);
    bf16* XB1 = (bf16*)(ws + WS_XB1); bf16* HB = (bf16*)(ws + WS_H); bf16* QX = (bf16*)(ws + WS_QX); bf16* OX = (bf16*)(ws + WS_OX);
    const int bx = (int)blockIdx.x;

    if (IN(0)) { p0_prologue(F, P); }
    SEAM(0);
    if (IN(1)) {
        pg8::Gemm g{XN, Win, D, 64}; pg8::StaticOrder S; S.init(M / 256, NPROJ / 256, F.G, bx);
        EpiProj E{LAT, KR, RQ, RK, RV, RG, SSQL, CS};
        pg8::gemm_phase(F.lds, g, S, E);
    }
    SEAM(1);
    if (IN(2)) {
        { pg8::Gemm g{LAT, Wup, NLAT, 64}; pg8::StaticOrder S; S.init(M / 256, NUP / 256, F.G, bx); EpiUp E{QKV, SSQL, CS}; pg8::gemm_phase(F.lds, g, S, E); }
        { pg8::Gemm g{MEMN, Wxkv, D, 64}; pg8::StaticOrder S; S.init(4, 8, F.G, (bx + 64) % F.G); EpiStore E{MKV, 2048, nullptr, 1.0f}; pg8::gemm_phase(F.lds, g, S, E); }
        __syncthreads();
        for (int U = F.vcu; U < 512; U += F.G) ret_kv_unit(F, U, RK, RV, KVT);
    }
    SEAM(2);
    if (IN(3)) {
        if (!(args.flags & 1)) ret_scan(F, KVT);
        for (int v = F.vcu; v < 256; v += F.G) { const int bh = v >> 3, s = v & 7;
            mla_unit(F, bh >> 3, bh & 7, 15 - s, QKV, KR, Y); mla_unit(F, bh >> 3, bh & 7, s, QKV, KR, Y); }
    }
    SEAM(3);
    if (IN(4)) { for (int p = F.vcu; p < 256; p += F.G) ret_out_pair(F, p, RQ, RK, RV, RG, KVT, Y); }
    SEAM(4);
    if (IN(5)) { pg8::Gemm g{Y, Wout, D, 64}; pg8::StaticOrder S; S.init(M / 256, 4, F.G, bx); EpiRes E{P.x, P.out, XB1, SSQ1}; pg8::gemm_phase(F.lds, g, S, E); }
    SEAM(5);
    if (IN(6)) { pg8::Gemm g{XB1, Wxq, D, 64}; pg8::StaticOrder S; S.init(M / 256, 4, F.G, bx); EpiStore E{QX, D, SSQ1, C2_X}; pg8::gemm_phase(F.lds, g, S, E); }
    SEAM(6);
    if (IN(7)) { for (int u = F.vcu; u < 256; u += F.G) xattn_unit(F, u >> 2, u & 3, QX, MKV, OX); }
    SEAM(7);
    if (IN(8)) { pg8::Gemm g{OX, Wxo, D, 64}; pg8::StaticOrder S; S.init(M / 256, 4, F.G, bx); EpiRes E{P.out, P.out, XB2, SSQ2}; pg8::gemm_phase(F.lds, g, S, E); }
    SEAM(8);
    if (IN(9)) { pg8::Gemm g{XB2 - 2 * D, Wffi, D, FF_BLK}; pg8::StaticOrder S; S.init(FF_NM, NFF / 256, F.G, bx); EpiFfn E{HB, SSQ2, P.conv_w, P.conv_b}; pg8::gemm_phase(F.lds, g, S, E); }
    SEAM(9);
    if (IN(10)) { pg8::Gemm g{HB, Wffo, DFF, 64}; pg8::StaticOrder S; S.init(M / 256, 4, F.G, bx); EpiRes E{P.out, P.out, nullptr, nullptr}; pg8::gemm_phase(F.lds, g, S, E); }
    SEAM(10);
    if (IN(11)) {
        const int gw = F.vcu * NWAVES + F.wave, NGW = F.G * NWAVES, lane = F.lane;
        for (int m = gw; m < M; m += NGW) {
            f32x4* xr = (f32x4*)(P.out + (size_t)m * D) + lane; f32x4 v[4]; float s = 0.f;
#pragma unroll
            for (int j = 0; j < 4; ++j) { v[j] = xr[64 * j]; s += (v[j][0] * v[j][0] + v[j][1] * v[j][1]) + (v[j][2] * v[j][2] + v[j][3] * v[j][3]); }
            const float inv = 1.0f / sqrtf(wave_sum(s) * (1.0f / D) + EPS);
#pragma unroll
            for (int j = 0; j < 4; ++j) xr[64 * j] = v[j] * inv * ((const f32x4*)P.g_final)[lane + 64 * j];
        }
    }
#undef IN
#undef SEAM
}

extern "C" void kernel_launch(void* const* d_in, const int* in_sizes, int n_in, void* d_out, int out_size, void* d_ws, size_t ws_size, hipStream_t stream) {
    static int grid = 0;
    if (grid == 0) {
        int dev = 0, cus = 0;
        if (n_in != 21 || out_size != M * D || ws_size < WS_END) { fprintf(stderr, "kernel_launch: unexpected problem (n_in %d, out %d, ws %zu); nothing launched\n", n_in, out_size, ws_size); grid = -1; return; }
        if (hipGetDevice(&dev) != hipSuccess || hipDeviceGetAttribute(&cus, hipDeviceAttributeMultiprocessorCount, dev) != hipSuccess) { grid = -1; return; }
        if (hipFuncSetAttribute((const void*)hymba_fwd, hipFuncAttributeMaxDynamicSharedMemorySize, LDS_BYTES) != hipSuccess) { fprintf(stderr, "kernel_launch: hipFuncSetAttribute failed\n"); grid = -1; return; }
        int per_cu = 0;
        if (hipOccupancyMaxActiveBlocksPerMultiprocessor(&per_cu, (const void*)hymba_fwd, NWAVES * 64, LDS_BYTES) != hipSuccess || per_cu < 1) fprintf(stderr, "kernel_launch: occupancy query says %d blocks per CU\n", per_cu);
        (void)hipGetLastError();
        grid = cus;
    }
    if (grid < 0) return;
    if (hipMemsetAsync((char*)d_ws + WS_CTL, 0, CTL_ZERO_BYTES, stream) != hipSuccess) return;
    Args a{};
    for (int i = 0; i < 21; ++i) a.in[i] = d_in[i];
    a.out = (float*)d_out; a.ws = (unsigned char*)d_ws;
#ifdef PROBE_PHASE
    a.ph_lo = 0; a.ph_hi = PROBE_PHASE + 1; hipLaunchKernelGGL(hymba_fwd, dim3(grid), dim3(NWAVES * 64), LDS_BYTES, stream, a);
    a.ph_lo = PROBE_PHASE; a.ph_hi = PROBE_PHASE + 1; a.flags = 1; a.li = 1; hipLaunchKernelGGL(hymba_fwd, dim3(grid), dim3(NWAVES * 64), LDS_BYTES, stream, a);
    a.ph_lo = PROBE_PHASE + 1; a.ph_hi = N_PHASES; a.flags = 0; a.li = 2; hipLaunchKernelGGL(hymba_fwd, dim3(grid), dim3(NWAVES * 64), LDS_BYTES, stream, a);
#else
    if (MK_N_LAUNCHES == 1) { a.ph_lo = 0; a.ph_hi = N_PHASES; hipLaunchKernelGGL(hymba_fwd, dim3(grid), dim3(NWAVES * 64), LDS_BYTES, stream, a); }
#endif
#ifndef PROBE_PHASE
    else for (int p = 0; p < N_PHASES; ++p) { a.ph_lo = p; a.ph_hi = p + 1; hipLaunchKernelGGL(hymba_fwd, dim3(grid), dim3(NWAVES * 64), LDS_BYTES, stream, a); }
#endif
}
```

```cpp
#include <hip/hip_runtime.h>
#include <cstdio>
#include <cstdint>
#include <cmath>

#ifndef MK_N_LAUNCHES
#define MK_N_LAUNCHES 1
#endif

typedef unsigned short bf16;
typedef short bf16x8 __attribute__((ext_vector_type(8)));
typedef short s16x4 __attribute__((ext_vector_type(4)));
typedef float f32x4 __attribute__((ext_vector_type(4)));
typedef float f32x2 __attribute__((ext_vector_type(2)));
typedef float f32x16 __attribute__((ext_vector_type(16)));
typedef unsigned u32x4 __attribute__((ext_vector_type(4)));
typedef unsigned u32x2 __attribute__((ext_vector_type(2)));
#define LAS __attribute__((address_space(3)))
#define GAS __attribute__((address_space(1)))
typedef GAS unsigned gu32;

constexpr int NB = 4, SEQ = 4096, D = 1024, M = NB * SEQ;
constexpr int NPROJ = 2560;
constexpr int NLAT = 384;
constexpr int NUP = 1792;
constexpr int DFF = 2816, NFF = 2 * DFF;
constexpr float EPS = 1e-6f;
constexpr float LOG2E = 1.4426950408889634f;
constexpr float C2_MLA = 0.10206207261596575f * LOG2E;
constexpr float C2_X = 0.0625f * LOG2E;
constexpr float RET_KSCALE = 0.08838834764831845f;
constexpr int FF_BLK = 62, FF_TROWS = 4 * FF_BLK, FF_NM = (M + FF_TROWS - 1) / FF_TROWS;

constexpr size_t MiB = 1u << 20;
constexpr size_t WS_CTL = 0, CTL_ZERO_BYTES = 1 * MiB;
constexpr size_t WS_WIN = 1 * MiB;
constexpr size_t WS_WUP = 6 * MiB;
constexpr size_t WS_WOUT = 8 * MiB, WS_WXQ = 10 * MiB, WS_WXKV = 12 * MiB, WS_WXO = 16 * MiB;
constexpr size_t WS_WFFI = 18 * MiB;
constexpr size_t WS_WFFO = 29 * MiB;
constexpr size_t WS_CS = 35 * MiB;
constexpr size_t WS_SSQL = 43 * MiB;
constexpr size_t WS_SSQ1 = 44 * MiB, WS_SSQ2 = 45 * MiB;
constexpr size_t WS_MEMN = 46 * MiB, WS_MKV = 48 * MiB;
constexpr size_t WS_A = 52 * MiB;
constexpr size_t WS_B = 84 * MiB;
constexpr size_t WS_LAT = WS_B, WS_KR = WS_B + 12 * MiB, WS_RQ = WS_B + 13 * MiB, WS_RK = WS_B + 29 * MiB, WS_RV = WS_B + 45 * MiB, WS_RG = WS_B + 61 * MiB;
constexpr size_t WS_C = 161 * MiB;
constexpr size_t WS_KVT = 217 * MiB;
constexpr size_t WS_XB1 = WS_B, WS_H = WS_B, WS_QX = 172 * MiB, WS_PX = 204 * MiB, WS_OX = 116 * MiB;
constexpr size_t WS_SUMP = 249 * MiB;
constexpr size_t WS_KH = WS_MKV, WS_VTH = WS_MKV + 2 * MiB;
constexpr size_t WS_END = 256 * MiB;
static_assert(WS_KVT + 32 * MiB <= WS_END && WS_PX + 32 * MiB <= WS_END && WS_SUMP + MiB <= WS_END && WS_H + (size_t)M * DFF * 2 <= WS_QX, "d_ws map");
constexpr int CW_TMO = 0, CW_BAR = 4096;

constexpr int RING_BYTES = 131072, LDSCTL_OFF = RING_BYTES, MISC_OFF = LDSCTL_OFF + 320, EPI_LDS_OFF = LDSCTL_OFF + 1024  , LDS_BYTES = 147456;

#define RLX_AGENT __ATOMIC_RELAXED, __HIP_MEMORY_SCOPE_AGENT
typedef __bf16 bf16x2_t __attribute__((ext_vector_type(2)));
__device__ __forceinline__ unsigned cvt_pk(float lo, float hi) { const f32x2 v = {lo, hi}; const bf16x2_t b = __builtin_convertvector(v, bf16x2_t); return __builtin_bit_cast(unsigned, b); }
__device__ __forceinline__ float bf2f(unsigned short b) { return __uint_as_float((unsigned)b << 16); }
__device__ __forceinline__ float wave_sum(float v) {
#pragma unroll
    for (int o = 1; o < 64; o <<= 1) v += __shfl_xor(v, o);
    return v;
}
__device__ __forceinline__ float silu_f(float x) { return x * __builtin_amdgcn_rcpf(1.0f + __builtin_amdgcn_exp2f(-x * LOG2E)); }
__device__ __forceinline__ int crow(int r, int hi) { return (r & 3) + 8 * (r >> 2) + 4 * hi; }
__device__ __forceinline__ bf16x8 pack8(float a0, float a1, float a2, float a3, float a4, float a5, float a6, float a7) {
    u32x4 w; w.x = cvt_pk(a0, a1); w.y = cvt_pk(a2, a3); w.z = cvt_pk(a4, a5); w.w = cvt_pk(a6, a7); return __builtin_bit_cast(bf16x8, w);
}
typedef short v4i16_t __attribute__((ext_vector_type(4)));
__device__ __forceinline__ s16x4 tr_read(const LAS unsigned char* p) { return __builtin_bit_cast(s16x4, __builtin_amdgcn_ds_read_tr16_b64_v4i16((LAS v4i16_t*)p)); }
__device__ __forceinline__ bf16x8 tr_frag(const LAS unsigned char* p0, const LAS unsigned char* p1) {
    const s16x4 lo = tr_read(p0), hi = tr_read(p1);
    return (bf16x8){lo[0], lo[1], lo[2], lo[3], hi[0], hi[1], hi[2], hi[3]};
}
template <class T> __device__ __forceinline__ T* at(T* base, unsigned byte_off) { return (T*)((char*)base + byte_off); }
template <class T> __device__ __forceinline__ const T* at(const T* base, unsigned byte_off) { return (const T*)((const char*)base + byte_off); }
#define MFMA32(a, b, c) __builtin_amdgcn_mfma_f32_32x32x16_bf16((a), (b), (c), 0, 0, 0)

namespace pg8 {
constexpr int BM = 256, BK = 64, HALF = 128, HTB = HALF * BK * 2, STAGE_BYTES = 8 * HTB, NXCD = 8, WGM = 8;
__host__ __device__ __forceinline__ int lds_byte(int r, int c) { const int st = (r >> 4) * 2 + (c >> 5), rr = r & 15, cc = c & 31, ob = rr * 64 + cc * 2; return st * 1024 + (ob ^ (((ob >> 9) & 1) << 5)); }
__host__ __device__ __forceinline__ void stage_rc(int b, int& R, int& C) { const int st = b / 1024, sb = b % 1024, swz = sb ^ (((sb >> 9) & 1) << 5); R = (st >> 1) * 16 + swz / 64; C = (st & 1) * 32 + (swz % 64) / 2; }
__host__ __device__ __forceinline__ int perm32(int rho) { const int n = rho >> 4, i = rho & 15; return 8 * (i >> 2) + 4 * n + (i & 3); }

struct Unit { int pm, pn; };
struct Gemm { const bf16* A; const bf16* Bt; int K; int a_blk; int a_pn; int b_pm; };

struct StaticOrder {
    int nM, nN, nwg, G, c;
    __device__ void init(int nM_, int nN_, int G_, int c_) { nM = nM_; nN = nN_; nwg = nM * nN; G = G_; c = c_; }
    __device__ bool next(int i, Unit& u) const {
        const long L = (long)i * G + c; if (L >= nwg) return false;
        int wgid = (int)L; { const int q = nwg / NXCD, r = nwg % NXCD, xcd = wgid % NXCD, off = wgid / NXCD; wgid = (xcd < r ? xcd * (q + 1) : r * (q + 1) + (xcd - r) * q) + off; }
        const int nig = WGM * nN, gid = wgid / nig, fm = gid * WGM, gsz = (nM - fm) < WGM ? (nM - fm) : WGM;
        u.pm = fm + ((wgid % nig) % gsz); u.pn = (wgid % nig) / gsz; return true;
    }
};

template <class Epi>
__device__ __forceinline__ void gemm_phase(LAS unsigned char* lds, const Gemm g, const StaticOrder& S, const Epi& E) {
    int tid = threadIdx.x; asm volatile("" : "+v"(tid));
    const int wid = __builtin_amdgcn_readfirstlane(tid >> 6), lane = tid & 63, wr = wid >> 2, wc = wid & 3, fr = lane & 15, fq = lane >> 4;
    const int K = g.K, nt = K / BK;
    unsigned voffA[2], voffB[2];
#pragma unroll
    for (int i = 0; i < 2; ++i) { int R, C; stage_rc(tid * 16 + i * 8192, R, C); const int Rb = (R & ~31) + perm32(R & 31); const int Ra = (R >> 6) * g.a_blk + (R & 63);
        voffA[i] = (unsigned)(Ra * K + C) * 2u; voffB[i] = (unsigned)(Rb * K + C) * 2u; }
    const size_t kstep = (size_t)(BK * 2);
    const size_t hstepA = (size_t)2 * g.a_blk * K * 2, tstepA = 2 * hstepA;
    const size_t hstepB = (size_t)HALF * K * 2, tstepB = 2 * hstepB;
    const unsigned ldsw = (unsigned)wid * 1024u;
    const int aoff = lds_byte(wr * 64 + fr, fq * 8), boff = lds_byte(wc * 32 + fr, fq * 8);
#define PG8_SA(b, h) (((b) * 2 + (h)) * HTB)
#define PG8_SB(b, h) ((4 + (b) * 2 + (h)) * HTB)
#define PG8_STAGE(bufoff, gbase, voff) do { _Pragma("unroll") for (int _i = 0; _i < 2; ++_i) \
        __builtin_amdgcn_global_load_lds((const unsigned*)((const char*)(gbase) + (voff)[_i]), (LAS unsigned*)(lds + (bufoff) + ldsw + _i * 8192), 16, 0, 0); } while (0)
#define PG8_LDA(dst, b, h) do { _Pragma("unroll") for (int m = 0; m < 4; ++m) _Pragma("unroll") for (int k = 0; k < 2; ++k) dst[m][k] = *(const LAS bf16x8*)(lds + PG8_SA(b, h) + aoff + m * 2048 + k * 1024); } while (0)
#define PG8_LDB(dst, b, h) do { _Pragma("unroll") for (int n = 0; n < 2; ++n) _Pragma("unroll") for (int k = 0; k < 2; ++k) dst[n][k] = *(const LAS bf16x8*)(lds + PG8_SB(b, h) + boff + n * 2048 + k * 1024); } while (0)
#define PG8_MMA(ai, bj, At, Bt) do { __builtin_amdgcn_s_setprio(1); _Pragma("unroll") for (int m = 0; m < 4; ++m) _Pragma("unroll") for (int n = 0; n < 2; ++n) _Pragma("unroll") for (int k = 0; k < 2; ++k) \
        acc[ai][bj][m][n] = __builtin_amdgcn_mfma_f32_16x16x32_bf16(Bt[n][k], At[m][k], acc[ai][bj][m][n], 0, 0, 0); __builtin_amdgcn_s_setprio(0); } while (0)
#define PG8_WAIT_V(n) asm volatile("s_waitcnt vmcnt(" #n ")" ::: "memory")
#define PG8_WAIT_L(n) asm volatile("s_waitcnt lgkmcnt(" #n ")" ::: "memory")
#define PG8_BAR __builtin_amdgcn_s_barrier()
#define PG8_SCHED __builtin_amdgcn_sched_barrier(0)
    Unit cur, nxt; int ui = 0;
    if (!S.next(0, cur)) return;
    f32x4 acc[2][2][4][2];
#pragma unroll
    for (int a = 0; a < 2; ++a)
#pragma unroll
        for (int b = 0; b < 2; ++b)
#pragma unroll
            for (int m = 0; m < 4; ++m)
#pragma unroll
                for (int n = 0; n < 2; ++n) acc[a][b][m][n] = (f32x4){0.f, 0.f, 0.f, 0.f};
    bf16x8 At[4][2], B0[2][2], B1[2][2];
    const char* cA = (const char*)g.A + (size_t)(cur.pm + cur.pn * g.a_pn) * tstepA; const char* cB = (const char*)g.Bt + (size_t)(cur.pn + (cur.pm >> 4) * g.b_pm) * tstepB;
    PG8_STAGE(PG8_SB(0, 0), cB, voffB); PG8_STAGE(PG8_SB(0, 1), cB + hstepB, voffB); PG8_STAGE(PG8_SA(0, 0), cA, voffA); PG8_STAGE(PG8_SA(0, 1), cA + hstepA, voffA);
    if (wr == 1) PG8_BAR;
    PG8_WAIT_V(2); PG8_BAR;
    PG8_STAGE(PG8_SB(1, 0), cB + kstep, voffB); PG8_STAGE(PG8_SA(1, 0), cA + kstep, voffA); PG8_STAGE(PG8_SB(1, 1), cB + hstepB + kstep, voffB);
    PG8_WAIT_V(6); PG8_BAR;
    for (;;) {
        const bool has_next = S.next(ui + 1, nxt);
        const char* nA = has_next ? (const char*)g.A + (size_t)(nxt.pm + nxt.pn * g.a_pn) * tstepA : cA; const char* nB = has_next ? (const char*)g.Bt + (size_t)(nxt.pn + (nxt.pm >> 4) * g.b_pm) * tstepB : cB;
#pragma unroll 1
        for (int t = 0; t < nt; t += 2) {
            const bool last = (t == nt - 2);
            const char* a1 = cA + (size_t)(t + 1) * kstep;
            const char* a2 = last ? nA : cA + (size_t)(t + 2) * kstep; const char* b2 = last ? nB : cB + (size_t)(t + 2) * kstep;
            const char* a3 = a2 + kstep; const char* b3 = b2 + kstep;
            PG8_LDB(B0, 0, 0); PG8_LDB(B1, 0, 1); PG8_SCHED; PG8_LDA(At, 0, 0); PG8_STAGE(PG8_SA(1, 1), a1 + hstepA, voffA);
            PG8_WAIT_V(8); PG8_WAIT_L(0); PG8_BAR; PG8_MMA(0, 0, At, B0); PG8_MMA(0, 1, At, B1); PG8_BAR; PG8_SCHED;
            PG8_LDA(At, 0, 1); PG8_STAGE(PG8_SB(0, 0), b2, voffB); PG8_STAGE(PG8_SB(0, 1), b2 + hstepB, voffB); PG8_STAGE(PG8_SA(0, 0), a2, voffA);
            PG8_WAIT_V(8); PG8_WAIT_L(0); PG8_BAR; PG8_MMA(1, 0, At, B0); PG8_MMA(1, 1, At, B1); PG8_BAR; PG8_SCHED;
            PG8_LDB(B0, 1, 0); PG8_LDB(B1, 1, 1); PG8_SCHED; PG8_LDA(At, 1, 0); PG8_STAGE(PG8_SA(0, 1), a2 + hstepA, voffA);
            PG8_WAIT_V(8); PG8_WAIT_L(0); PG8_BAR; PG8_MMA(0, 0, At, B0); PG8_MMA(0, 1, At, B1); PG8_BAR; PG8_SCHED;
            PG8_LDA(At, 1, 1); PG8_STAGE(PG8_SB(1, 0), b3, voffB); PG8_STAGE(PG8_SB(1, 1), b3 + hstepB, voffB); PG8_STAGE(PG8_SA(1, 0), a3, voffA);
            PG8_WAIT_V(8); PG8_WAIT_L(0); PG8_BAR; PG8_MMA(1, 0, At, B0); PG8_MMA(1, 1, At, B1); PG8_BAR; PG8_SCHED;
        }
        if (wr == 0) PG8_BAR;
        E(acc, cur, wr, wc, fr, fq, lds);
        if (!has_next) break;
#pragma unroll
        for (int a = 0; a < 2; ++a)
#pragma unroll
            for (int b = 0; b < 2; ++b)
#pragma unroll
                for (int m = 0; m < 4; ++m)
#pragma unroll
                    for (int n = 0; n < 2; ++n) acc[a][b][m][n] = (f32x4){0.f, 0.f, 0.f, 0.f};
        cur = nxt; cA = nA; cB = nB; ++ui;
        if (wr == 1) PG8_BAR;
    }
    PG8_WAIT_V(0);
    PG8_BAR;
#undef PG8_SA
#undef PG8_SB
#undef PG8_STAGE
#undef PG8_LDA
#undef PG8_LDB
#undef PG8_MMA
#undef PG8_WAIT_V
#undef PG8_WAIT_L
#undef PG8_BAR
#undef PG8_SCHED
}
}

typedef f32x4 Acc[2][2][4][2];
__device__ __forceinline__ void st8bf(bf16* p, const f32x4 a, const f32x4 b) { u32x4 w; w.x = cvt_pk(a[0], a[1]); w.y = cvt_pk(a[2], a[3]); w.z = cvt_pk(b[0], b[1]); w.w = cvt_pk(b[2], b[3]); *(u32x4*)p = w; }
__device__ __forceinline__ float ssq8(const f32x4 a, const f32x4 b) { return (a[0] * a[0] + a[1] * a[1]) + (a[2] * a[2] + a[3] * a[3]) + (b[0] * b[0] + b[1] * b[1]) + (b[2] * b[2] + b[3] * b[3]); }
__device__ __forceinline__ float red_fq(float s) { s += __shfl_xor(s, 16); s += __shfl_xor(s, 32); return s; }
__device__ __forceinline__ f32x4 rot2(const f32x4 v, const f32x4 cs) { return (f32x4){v[0] * cs[0] - v[1] * cs[1], v[1] * cs[0] + v[0] * cs[1], v[2] * cs[2] - v[3] * cs[3], v[3] * cs[2] + v[2] * cs[3]}; }

struct EpiProj {
    bf16 *LAT, *KR, *RQ, *RK, *RV, *RG; float* SSQL; const float* CS;
    __device__ __forceinline__ void operator()(const Acc& acc, const pg8::Unit& u, int wr, int wc, int fr, int fq, LAS unsigned char*) const {
        const int pn = u.pn;
#pragma unroll
        for (int ai = 0; ai < 2; ++ai)
#pragma unroll
            for (int m = 0; m < 4; ++m) {
                const int row = u.pm * 256 + ai * 128 + wr * 64 + m * 16 + fr;
                const int cw = 32 * wc + 8 * fq;
                if (pn == 0) {
                    float s = 0.f;
#pragma unroll
                    for (int bj = 0; bj < 2; ++bj) { st8bf(at(LAT, (unsigned)(row * NLAT + bj * 128 + cw) * 2u), acc[ai][bj][m][0], acc[ai][bj][m][1]); s += ssq8(acc[ai][bj][m][0], acc[ai][bj][m][1]); }
                    s = red_fq(s); if (fq == 0) *at(SSQL, (unsigned)(row * 8 + wc) * 4u) = s;
                } else if (pn == 1) {
                    st8bf(at(LAT, (unsigned)(row * NLAT + 256 + cw) * 2u), acc[ai][0][m][0], acc[ai][0][m][1]);
                    float s = red_fq(ssq8(acc[ai][0][m][0], acc[ai][0][m][1])); if (fq == 0) *at(SSQL, (unsigned)(row * 8 + 4 + wc) * 4u) = s;
                    if (wc == 0) {
                        const float* cs = at(CS, (unsigned)row * 512u);
                        f32x4 o[2];
#pragma unroll
                        for (int n = 0; n < 2; ++n) { const int i0 = 4 * fq + 2 * n; const f32x2 a = *(const f32x2*)(cs + 8 * i0), b = *(const f32x2*)(cs + 8 * i0 + 8);
                            o[n] = rot2(acc[ai][1][m][n], (f32x4){a[0], a[1], b[0], b[1]}); }
                        st8bf(at(KR, (unsigned)(row * 32 + 8 * fq) * 2u), o[0], o[1]);
                    }
                } else if (pn < 6) {
                    const float* cs = at(CS, (unsigned)row * 512u);
#pragma unroll
                    for (int bj = 0; bj < 2; ++bj) { const int head = 2 * (pn & 1) + bj; f32x4 o[2];
#pragma unroll
                        for (int n = 0; n < 2; ++n) { const int i0 = (cw + 4 * n) >> 1; o[n] = rot2(acc[ai][bj][m][n], *(const f32x4*)(cs + 2 * i0)); }
                        if (pn < 4) st8bf(at(RQ, (unsigned)(row * 512 + head * 128 + cw) * 2u), o[0], o[1]);
                        else { const float lg = __builtin_amdgcn_logf(1.0f - __builtin_amdgcn_exp2f(-5.0f - (float)head));
                            const float w = RET_KSCALE * __builtin_amdgcn_exp2f((float)(127 - (row & 127)) * lg);
                            st8bf(at(RK, (unsigned)(row * 512 + head * 128 + cw) * 2u), o[0] * w, o[1] * w); } }
                } else if (pn < 8) {
#pragma unroll
                    for (int bj = 0; bj < 2; ++bj) st8bf(at(RV, (unsigned)(row * 512 + (pn & 1) * 256 + bj * 128 + cw) * 2u), acc[ai][bj][m][0], acc[ai][bj][m][1]);
                } else {
#pragma unroll
                    for (int bj = 0; bj < 2; ++bj) { f32x4 a = acc[ai][bj][m][0], b = acc[ai][bj][m][1];
#pragma unroll
                        for (int e = 0; e < 4; ++e) { a[e] = silu_f(a[e]); b[e] = silu_f(b[e]); }
                        st8bf(at(RG, (unsigned)(row * 512 + (pn & 1) * 256 + bj * 128 + cw) * 2u), a, b); }
                }
            }
    }
};

struct EpiUp {
    bf16* QKV; const float* SSQL; const float* CS;
    __device__ __forceinline__ void operator()(const Acc& acc, const pg8::Unit& u, int wr, int wc, int fr, int fq, LAS unsigned char*) const {
        const bool isq = u.pn < 3;
#pragma unroll
        for (int ai = 0; ai < 2; ++ai)
#pragma unroll
            for (int m = 0; m < 4; ++m) {
                const int row = u.pm * 256 + ai * 128 + wr * 64 + m * 16 + fr;
                const f32x4 sq = *(const f32x4*)at(SSQL, (unsigned)(row * 8 + (isq ? 0 : 4)) * 4u);
                const float inv = 1.0f / sqrtf(((sq[0] + sq[1]) + (sq[2] + sq[3])) * (isq ? 1.0f / 256.0f : 1.0f / 128.0f) + EPS);
                const float sc = isq ? inv * C2_MLA : inv;
                const float* cs = at(CS, (unsigned)row * 512u);
#pragma unroll
                for (int bj = 0; bj < 2; ++bj) { const int col = u.pn * 256 + bj * 128 + 32 * wc + 8 * fq; f32x4 o[2];
#pragma unroll
                    for (int n = 0; n < 2; ++n) { o[n] = acc[ai][bj][m][n] * sc; const int hc = (col + 4 * n) % 96;
                        if (isq && hc >= 64) { const int i0 = (hc - 64) >> 1; const f32x2 a = *(const f32x2*)(cs + 8 * i0), b = *(const f32x2*)(cs + 8 * i0 + 8); o[n] = rot2(o[n], (f32x4){a[0], a[1], b[0], b[1]}); } }
                    st8bf(at(QKV, (unsigned)(row * NUP + col) * 2u), o[0], o[1]); }
                asm volatile("" ::: "memory");
            }
    }
};

struct EpiStore {
    bf16* O; int ldc; const float* SSQ16; float scale;
    __device__ __forceinline__ void operator()(const Acc& acc, const pg8::Unit& u, int wr, int wc, int fr, int fq, LAS unsigned char*) const {
#pragma unroll
        for (int ai = 0; ai < 2; ++ai)
#pragma unroll
            for (int m = 0; m < 4; ++m) {
                const int row = u.pm * 256 + ai * 128 + wr * 64 + m * 16 + fr;
                float sc = scale;
                if (SSQ16) { const f32x4* p = (const f32x4*)at(SSQ16, (unsigned)row * 64u); const f32x4 a = p[0], b = p[1], c = p[2], d = p[3];
                    const float t = ((a[0] + a[1]) + (a[2] + a[3])) + ((b[0] + b[1]) + (b[2] + b[3])) + ((c[0] + c[1]) + (c[2] + c[3])) + ((d[0] + d[1]) + (d[2] + d[3]));
                    sc *= 1.0f / sqrtf(t * (1.0f / 1024.0f) + EPS); }
#pragma unroll
                for (int bj = 0; bj < 2; ++bj) st8bf(at(O, (unsigned)(row * ldc + u.pn * 256 + bj * 128 + 32 * wc + 8 * fq) * 2u), acc[ai][bj][m][0] * sc, acc[ai][bj][m][1] * sc);
            }
    }
};

struct EpiTile {
    bf16* O; int tm, tn; const float* SSQ16; float scale;
    __device__ __forceinline__ void operator()(const Acc& acc, const pg8::Unit& u, int wr, int wc, int fr, int fq, LAS unsigned char*) const {
        bf16* T = O + (size_t)(u.pm * tm + u.pn * tn) * 65536;
#pragma unroll
        for (int ai = 0; ai < 2; ++ai)
#pragma unroll
            for (int m = 0; m < 4; ++m) {
                const int rl = ai * 128 + wr * 64 + m * 16 + fr;
                float sc = scale;
                if (SSQ16) { const f32x4* p = (const f32x4*)at(SSQ16, (unsigned)(u.pm * 256 + rl) * 64u); const f32x4 a = p[0], b = p[1], c = p[2], d = p[3];
                    const float t = ((a[0] + a[1]) + (a[2] + a[3])) + ((b[0] + b[1]) + (b[2] + b[3])) + ((c[0] + c[1]) + (c[2] + c[3])) + ((d[0] + d[1]) + (d[2] + d[3]));
                    sc *= 1.0f / sqrtf(t * (1.0f / 1024.0f) + EPS); }
#pragma unroll
                for (int bj = 0; bj < 2; ++bj) st8bf(at(T, (unsigned)(rl * 256 + bj * 128 + 32 * wc + 8 * fq) * 2u), acc[ai][bj][m][0] * sc, acc[ai][bj][m][1] * sc);
            }
    }
};
struct EpiSoftmax {
    bf16* PX; float* SUMP;
    __device__ __forceinline__ void operator()(const Acc& acc, const pg8::Unit& u, int wr, int wc, int fr, int fq, LAS unsigned char* lds) const {
        LAS float* PM = (LAS float*)(lds + EPI_LDS_OFF);
#pragma unroll
        for (int ai = 0; ai < 2; ++ai)
#pragma unroll
            for (int m = 0; m < 4; ++m) {
                float mx = -INFINITY;
#pragma unroll
                for (int bj = 0; bj < 2; ++bj)
#pragma unroll
                    for (int n = 0; n < 2; ++n) { const f32x4 v = acc[ai][bj][m][n]; mx = fmaxf(fmaxf(mx, fmaxf(v[0], v[1])), fmaxf(v[2], v[3])); }
                mx = fmaxf(mx, __shfl_xor(mx, 16)); mx = fmaxf(mx, __shfl_xor(mx, 32));
                if (fq == 0) PM[(ai * 128 + wr * 64 + m * 16 + fr) * 4 + wc] = mx;
            }
        asm volatile("s_waitcnt lgkmcnt(0)\n\ts_barrier" ::: "memory");
        bf16* T = PX + (size_t)(u.pn * (M / 256) + u.pm) * 65536;
#pragma unroll
        for (int ai = 0; ai < 2; ++ai)
#pragma unroll
            for (int m = 0; m < 4; ++m) {
                const int rl = ai * 128 + wr * 64 + m * 16 + fr;
                const f32x4 pm4 = *(const LAS f32x4*)(PM + rl * 4);
                const float mx = fmaxf(fmaxf(pm4[0], pm4[1]), fmaxf(pm4[2], pm4[3]));
                float s = 0.f;
#pragma unroll
                for (int bj = 0; bj < 2; ++bj) { f32x4 a = acc[ai][bj][m][0], b = acc[ai][bj][m][1];
#pragma unroll
                    for (int e = 0; e < 4; ++e) { a[e] = __builtin_amdgcn_exp2f(a[e] - mx); b[e] = __builtin_amdgcn_exp2f(b[e] - mx); }
                    s += ((a[0] + a[1]) + (a[2] + a[3])) + ((b[0] + b[1]) + (b[2] + b[3]));
                    st8bf(at(T, (unsigned)(rl * 256 + bj * 128 + 32 * wc + 8 * fq) * 2u), a, b); }
                s = red_fq(s); if (fq == 0) *at(SUMP, (unsigned)((u.pm * 256 + rl) * 16 + u.pn * 4 + wc) * 4u) = s;
            }
        asm volatile("s_waitcnt lgkmcnt(0)\n\ts_barrier" ::: "memory");
    }
};
struct EpiPV {
    bf16* OX; const float* SUMP;
    __device__ __forceinline__ void operator()(const Acc& acc, const pg8::Unit& u, int wr, int wc, int fr, int fq, LAS unsigned char*) const {
#pragma unroll
        for (int ai = 0; ai < 2; ++ai)
#pragma unroll
            for (int m = 0; m < 4; ++m) {
                const int row = u.pm * 256 + ai * 128 + wr * 64 + m * 16 + fr;
                const f32x4 sp = *(const f32x4*)at(SUMP, (unsigned)(row * 16 + u.pn * 4) * 4u);
                const float sc = 1.0f / ((sp[0] + sp[1]) + (sp[2] + sp[3]));
#pragma unroll
                for (int bj = 0; bj < 2; ++bj) st8bf(at(OX, (unsigned)(row * D + u.pn * 256 + bj * 128 + 32 * wc + 8 * fq) * 2u), acc[ai][bj][m][0] * sc, acc[ai][bj][m][1] * sc);
            }
    }
};

struct EpiRes {
    const float* base; float* out; bf16* XB; float* SSQ16;
    __device__ __forceinline__ void operator()(const Acc& acc, const pg8::Unit& u, int wr, int wc, int fr, int fq, LAS unsigned char*) const {
#pragma unroll
        for (int ai = 0; ai < 2; ++ai)
#pragma unroll
            for (int m = 0; m < 4; ++m) {
                const int row = u.pm * 256 + ai * 128 + wr * 64 + m * 16 + fr; float s = 0.f;
#pragma unroll
                for (int bj = 0; bj < 2; ++bj) { const unsigned off = (unsigned)(row * D + u.pn * 256 + bj * 128 + 32 * wc + 8 * fq);
                    const f32x4 a = *(const f32x4*)at(base, off * 4u) + acc[ai][bj][m][0], b = *(const f32x4*)at(base, off * 4u + 16u) + acc[ai][bj][m][1];
                    *(f32x4*)at(out, off * 4u) = a; *(f32x4*)at(out, off * 4u + 16u) = b;
                    if (XB) st8bf(at(XB, off * 2u), a, b);
                    s += ssq8(a, b); }
                if (SSQ16) { s = red_fq(s); if (fq == 0) *at(SSQ16, (unsigned)(row * 16 + u.pn * 4 + wc) * 4u) = s; }
                if (m & 1) asm volatile("" ::: "memory");
            }
    }
};

struct EpiFfn {
    bf16* H; const float* SSQ16; const float* cw; const float* cb;
    __device__ __forceinline__ void operator()(const Acc& acc, const pg8::Unit& u, int wr, int wc, int fr, int fq, LAS unsigned char*) const {
        const int lane = threadIdx.x & 63;
        const int colh = u.pn * 128 + 32 * wc + 8 * fq;
        f32x4 w0[2], w1[2], w2[2], bb[2];
#pragma unroll
        for (int n = 0; n < 2; ++n) { w0[n] = *(const f32x4*)(cw + colh + 4 * n); w1[n] = *(const f32x4*)(cw + DFF + colh + 4 * n); w2[n] = *(const f32x4*)(cw + 2 * DFF + colh + 4 * n); bb[n] = *(const f32x4*)(cb + colh + 4 * n); }
        const int src1 = (lane & 48) | ((fr + 15) & 15), src2 = (lane & 48) | ((fr + 14) & 15);
#pragma unroll
        for (int ai = 0; ai < 2; ++ai) {
            const int row0 = u.pm * FF_TROWS + (2 * ai + wr) * FF_BLK - 2;
            f32x4 gp[2] = {(f32x4){0.f, 0.f, 0.f, 0.f}, (f32x4){0.f, 0.f, 0.f, 0.f}};
#pragma unroll
            for (int m = 0; m < 4; ++m) {
                const int t = row0 + m * 16 + fr;
                const int tc = t < 0 ? 0 : (t >= M ? M - 1 : t);
                const f32x4* p = (const f32x4*)at(SSQ16, (unsigned)tc * 64u); const f32x4 a = p[0], b = p[1], c = p[2], d = p[3];
                const float tt = ((a[0] + a[1]) + (a[2] + a[3])) + ((b[0] + b[1]) + (b[2] + b[3])) + ((c[0] + c[1]) + (c[2] + c[3])) + ((d[0] + d[1]) + (d[2] + d[3]));
                const float inv = 1.0f / sqrtf(tt * (1.0f / 1024.0f) + EPS);
                const int ts = t & (SEQ - 1);
                f32x4 o[2], gc[2];
#pragma unroll
                for (int n = 0; n < 2; ++n) {
                    gc[n] = acc[ai][0][m][n] * inv;
#pragma unroll
                    for (int e = 0; e < 4; ++e) {
                        const float cur = gc[n][e], prv = gp[n][e];
                        float g1 = __shfl(fr == 15 ? prv : cur, src1), g0 = __shfl(fr >= 14 ? prv : cur, src2);
                        if (ts < 1) g1 = 0.f; if (ts < 2) g0 = 0.f;
                        const float cv = bb[n][e] + w0[n][e] * g0 + w1[n][e] * g1 + w2[n][e] * cur;
                        o[n][e] = silu_f(cv) * (acc[ai][1][m][n][e] * inv);
                    }
                    gp[n] = gc[n];
                }
                if ((m > 0 || fr >= 2) && t < M) st8bf(at(H, (unsigned)(t * DFF + colh) * 2u), o[0], o[1]);
                asm volatile("" ::: "memory");
            }
        }
    }
};

#define XB_TMO      128
#define XB_XCNT(j)  (256  + 64 * (j))
#define XB_XSUB(j)  (1280 + 64 * (j))
#define XB_XGEN(j)  (2304 + 64 * (j))
#define XB_TOP      3328
#define XB_TOPGEN   3392
#define XCD_BAR_WORDS 3456
#define XB_SPIN_CAP (1u << 18)
__device__ __forceinline__ unsigned xb_ld(unsigned* p)              { return __hip_atomic_load(p, __ATOMIC_RELAXED, __HIP_MEMORY_SCOPE_AGENT); }
__device__ __forceinline__ unsigned xb_add(unsigned* p, unsigned v) { return __hip_atomic_fetch_add(p, v, __ATOMIC_RELAXED, __HIP_MEMORY_SCOPE_AGENT); }
__device__ __forceinline__ unsigned xb_xcc_id() { return (unsigned)__builtin_amdgcn_s_getreg((3 << 11) | 20) & 0xFu; }
#define XB_SPIN(cond, bar) do { unsigned _sp = 0; while (cond) { __builtin_amdgcn_s_sleep(1); \
    if ((++_sp & 255u) == 0u) { if (xb_ld(&(bar)[XB_TMO])) break; if (_sp > XB_SPIN_CAP) { atomicAdd(&(bar)[XB_TMO], 1u); break; } } } } while (0)
struct XcdBarrier { unsigned* bar; unsigned x; volatile LAS unsigned* st; };
__device__ __forceinline__ XcdBarrier xcd_barrier_post(unsigned* bar, volatile LAS unsigned* st) {
    XcdBarrier b; b.bar = bar; b.x = xb_xcc_id(); b.st = st;
    if (threadIdx.x == 0) (void)xb_add(&bar[XB_XCNT(b.x)], 1u);
    return b;
}
__device__ __forceinline__ void xcd_barrier_complete(unsigned* bar, unsigned x, unsigned& nloc, unsigned& nx) {
    const unsigned G = gridDim.x * gridDim.y * gridDim.z;
    unsigned sum, cnt, mine, sp = 0u;
    for (;;) {
        sum = 0u; cnt = 0u; mine = 0u;
#pragma unroll
        for (unsigned j = 0; j < 16; ++j) { const unsigned c = xb_ld(&bar[XB_XCNT(j)]); sum += c; cnt += (c > 0u) ? 1u : 0u; mine = (j == x) ? c : mine; }
        if (sum == G) break;
        __builtin_amdgcn_s_sleep(1);
        if ((++sp & 255u) == 0u) { if (xb_ld(&bar[XB_TMO])) break; if (sp > XB_SPIN_CAP) { atomicAdd(&bar[XB_TMO], 1u); break; } }
    }
    nloc = mine > 0u ? mine : 1u; nx = cnt > 0u ? cnt : 1u;
}
__device__ __forceinline__ void xcd_barrier(const XcdBarrier& b) {
    asm volatile("s_waitcnt vmcnt(0)" ::: "memory");
    __syncthreads();
    if (threadIdx.x == 0) {
        unsigned* bar = b.bar;
        __builtin_amdgcn_s_waitcnt(0);
        unsigned nloc = b.st[0], nx = b.st[1];
        if (nloc == 0u) { xcd_barrier_complete(bar, b.x, nloc, nx); b.st[0] = nloc; b.st[1] = nx; }
        const unsigned old = xb_add(&bar[XB_XSUB(b.x)], 1u);
        const unsigned gen = old / nloc;
        if (old + 1u == (gen + 1u) * nloc) {
            __builtin_amdgcn_fence(__ATOMIC_RELEASE, "agent");
            asm volatile("s_waitcnt vmcnt(0)" ::: "memory");
            const unsigned og = xb_add(&bar[XB_TOP], 1u);
            const unsigned tg = og / nx;
            if (og + 1u == (tg + 1u) * nx) xb_add(&bar[XB_TOPGEN], 1u);
            else XB_SPIN(xb_ld(&bar[XB_TOPGEN]) == tg, bar);
            __builtin_amdgcn_fence(__ATOMIC_ACQUIRE, "agent");
            xb_add(&bar[XB_XGEN(b.x)], 1u);
            asm volatile("s_waitcnt vmcnt(0)" ::: "memory");
        } else {
            XB_SPIN(xb_ld(&bar[XB_XGEN(b.x)]) == gen, bar);
            __builtin_amdgcn_fence(__ATOMIC_ACQUIRE, "agent");
            asm volatile("s_waitcnt vmcnt(0)" ::: "memory");
        }
    }
    __syncthreads();
}

constexpr int NWAVES = 8;
struct Frame {
    LAS unsigned char* lds; int tid, lane, wave, vcu, G;
};

__device__ __forceinline__ int map_proj(int n) {
    if (n < 384) return n;
    if (n < 416) { const int j = n - 384; return 384 + (j >> 1) + 16 * (j & 1); }
    if (n < 512) return -1;
    if (n < 1536) { const int j = n - 512, hd = j >> 7, c = j & 127; return 416 + hd * 128 + (c >> 1) + 64 * (c & 1); }
    return n - 1536 + 1440;
}
__device__ __forceinline__ int map_uq(int n) { const int h = n / 96, c = n % 96; if (c < 64) return n; const int j = c - 64; return h * 96 + 64 + (j >> 1) + 16 * (j & 1); }
__device__ __forceinline__ int map_ffi(int n) { const int t = n >> 8, c = n & 255; return (c < 128) ? t * 128 + c : DFF + t * 128 + (c - 128); }

template <int MAP>
__device__ __forceinline__ void transpose_item(const float* W, int K, int Nsrc, int Ndst, const float* g, bf16* WT, int ldk, int koff, int row_off, LAS float* scr, int item, int lane) {
    const int nblk = Ndst / 32, kb = item / nblk, nb = item % nblk, k0 = 64 * kb, n0 = 32 * nb;
    const int nd = n0 + (lane & 31);
    const int ns = MAP == 0 ? nd : (MAP == 1 ? map_proj(nd) : (MAP == 2 ? map_uq(nd) : map_ffi(nd)));
#pragma unroll 8
    for (int i = 0; i < 32; ++i) { const int kk = 2 * i + (lane >> 5); float v = 0.f; if (ns >= 0) { v = W[(size_t)(k0 + kk) * Nsrc + ns]; if (g) v *= g[k0 + kk]; } scr[kk * 33 + (lane & 31)] = v; }
    asm volatile("s_waitcnt lgkmcnt(0)" ::: "memory");
    const int c = lane & 7;
#pragma unroll
    for (int j = 0; j < 4; ++j) { const int n = (lane >> 3) + 8 * j; const LAS float* s = scr + (8 * c) * 33 + n;
        u32x4 o; o.x = cvt_pk(s[0 * 33], s[1 * 33]); o.y = cvt_pk(s[2 * 33], s[3 * 33]); o.z = cvt_pk(s[4 * 33], s[5 * 33]); o.w = cvt_pk(s[6 * 33], s[7 * 33]);
        *(u32x4*)(WT + (size_t)(row_off + n0 + n) * ldk + koff + k0 + 8 * c) = o; }
    asm volatile("s_waitcnt lgkmcnt(0)" ::: "memory");
}
__device__ __forceinline__ void rms_row_to_bf16(const float* xrow, const float* g, bf16* orow, int lane) {
    const f32x4* xr = (const f32x4*)xrow + lane;
    f32x4 v[4]; float s = 0.f;
#pragma unroll
    for (int j = 0; j < 4; ++j) { v[j] = xr[64 * j]; s += (v[j][0] * v[j][0] + v[j][1] * v[j][1]) + (v[j][2] * v[j][2] + v[j][3] * v[j][3]); }
    const float inv = 1.0f / sqrtf(wave_sum(s) * (1.0f / D) + EPS);
    u32x2* o8 = (u32x2*)orow + lane;
#pragma unroll
    for (int j = 0; j < 4; ++j) { f32x4 w = v[j] * inv; if (g) w = w * ((const f32x4*)g)[lane + 64 * j]; u32x2 t; t.x = cvt_pk(w[0], w[1]); t.y = cvt_pk(w[2], w[3]); o8[64 * j] = t; }
}

struct Ptrs {
    const float *x, *mem; const int* pos; const float *g_mix, *w_in, *g_q_lat, *w_uq, *g_kv_lat, *w_ukv, *w_out, *g_xattn, *g_mem, *w_xq, *w_xkv, *w_xo, *g_ffn, *w_ffn_in, *conv_w, *conv_b, *w_ffn_out, *g_final;
    float* out; unsigned char* ws;
};

__device__ __forceinline__ void p0_prologue(const Frame& F, const Ptrs& P) {
    LAS float* scr = (LAS float*)(F.lds + F.wave * 16384);
    const int gw = F.vcu * NWAVES + F.wave, NGW = F.G * NWAVES, lane = F.lane;
    unsigned char* ws = P.ws;
    bf16* Win = (bf16*)(ws + WS_WIN); bf16* Wup = (bf16*)(ws + WS_WUP);
    for (int i = gw * 64 + lane; i < 768 * 16 + 1024 * 32; i += NGW * 64) {
        if (i < 768 * 16) { const int r = i >> 4, c = i & 15; *(u32x4*)(Wup + (size_t)r * NLAT + 256 + 8 * c) = (u32x4){0u, 0u, 0u, 0u}; }
        else { const int j = i - 768 * 16, r = 768 + (j >> 5), c = j & 31; *(u32x4*)(Wup + (size_t)r * NLAT + 8 * c) = (u32x4){0u, 0u, 0u, 0u}; }
    }
    constexpr int I_IN = (D / 64) * (NPROJ / 32), I_UQ = (256 / 64) * (768 / 32), I_UKV = (128 / 64) * (1024 / 32), I_SQ = (D / 64) * (D / 32), I_XKV = (D / 64) * (2048 / 32), I_FFI = (D / 64) * (NFF / 32), I_FFO = (DFF / 64) * (D / 32);
    constexpr int NITEMS = I_IN + I_UQ + I_UKV + 3 * I_SQ + I_XKV + I_FFI + I_FFO;
    for (int it = gw; it < NITEMS; it += NGW) {
        int r = it;
        if (r < I_IN) { transpose_item<1>(P.w_in, D, 2464, NPROJ, P.g_mix, Win, D, 0, 0, scr, r, lane); continue; } r -= I_IN;
        if (r < I_UQ) { transpose_item<2>(P.w_uq, 256, 768, 768, P.g_q_lat, Wup, NLAT, 0, 0, scr, r, lane); continue; } r -= I_UQ;
        if (r < I_UKV) { transpose_item<0>(P.w_ukv, 128, 1024, 1024, P.g_kv_lat, Wup, NLAT, 256, 768, scr, r, lane); continue; } r -= I_UKV;
        if (r < I_SQ) { transpose_item<0>(P.w_out, D, D, D, nullptr, (bf16*)(ws + WS_WOUT), D, 0, 0, scr, r, lane); continue; } r -= I_SQ;
        if (r < I_SQ) { transpose_item<0>(P.w_xq, D, D, D, P.g_xattn, (bf16*)(ws + WS_WXQ), D, 0, 0, scr, r, lane); continue; } r -= I_SQ;
        if (r < I_SQ) { transpose_item<0>(P.w_xo, D, D, D, nullptr, (bf16*)(ws + WS_WXO), D, 0, 0, scr, r, lane); continue; } r -= I_SQ;
        if (r < I_XKV) { transpose_item<0>(P.w_xkv, D, 2048, 2048, nullptr, (bf16*)(ws + WS_WXKV), D, 0, 0, scr, r, lane); continue; } r -= I_XKV;
        if (r < I_FFI) { transpose_item<3>(P.w_ffn_in, D, NFF, NFF, P.g_ffn, (bf16*)(ws + WS_WFFI), D, 0, 0, scr, r, lane); continue; } r -= I_FFI;
        transpose_item<0>(P.w_ffn_out, DFF, D, D, nullptr, (bf16*)(ws + WS_WFFO), DFF, 0, 0, scr, r, lane);
    }
    bf16* XN = (bf16*)(ws + WS_A); bf16* MEMN = (bf16*)(ws + WS_MEMN); float* CS = (float*)(ws + WS_CS);
    for (int m = gw; m < M + NB * 256; m += NGW) {
        if (m < M) rms_row_to_bf16(P.x + (size_t)m * D, nullptr, XN + (size_t)m * D, lane);
        else rms_row_to_bf16(P.mem + (size_t)(m - M) * D, P.g_mem, MEMN + (size_t)(m - M) * D, lane);
    }
    for (int m = gw; m < M; m += NGW) {
        const float inv_freq = exp2f(-(float)lane * (13.287712379549449f / 64.0f));
        const float ang = (float)P.pos[m] * inv_freq;
        *(f32x2*)(CS + (size_t)m * 128 + 2 * lane) = (f32x2){cosf(ang), sinf(ang)};
    }
}

template <int NDT, int VP>
__device__ __forceinline__ void flash_step(f32x16& X0, f32x16& X1, f32x16 (&O)[NDT], float& mrun, float& lrun, const LAS unsigned char* vbase, LAS float* wsf, int lane) {
    const int hi = lane >> 5;
    float rm = X0[0];
#pragma unroll
    for (int r = 1; r < 16; ++r) rm = fmaxf(rm, X0[r]);
#pragma unroll
    for (int r = 0; r < 16; ++r) rm = fmaxf(rm, X1[r]);
    rm = fmaxf(rm, __shfl_xor(rm, 32));
    const float mnew = fmaxf(mrun, rm);
    const float alpha = __builtin_amdgcn_exp2f(mrun - mnew);
    mrun = mnew;
    float ps = 0.f;
#pragma unroll
    for (int r = 0; r < 16; ++r) { X0[r] = __builtin_amdgcn_exp2f(X0[r] - mnew); X1[r] = __builtin_amdgcn_exp2f(X1[r] - mnew); ps += X0[r] + X1[r]; }
    lrun = lrun * alpha + ps;
    if (__any(alpha != 1.0f)) {
        if (hi == 0) wsf[lane] = alpha;
        asm volatile("s_waitcnt lgkmcnt(0)" ::: "memory");
#pragma unroll
        for (int r = 0; r < 16; ++r) { const float a = wsf[crow(r, hi)];
#pragma unroll
            for (int dt = 0; dt < NDT; ++dt) O[dt][r] *= a; }
        asm volatile("s_waitcnt lgkmcnt(0)" ::: "memory");
    }
    const bf16x8 pa0 = pack8(X0[0], X0[1], X0[2], X0[3], X0[4], X0[5], X0[6], X0[7]), pa1 = pack8(X0[8], X0[9], X0[10], X0[11], X0[12], X0[13], X0[14], X0[15]);
    const bf16x8 pa2 = pack8(X1[0], X1[1], X1[2], X1[3], X1[4], X1[5], X1[6], X1[7]), pa3 = pack8(X1[8], X1[9], X1[10], X1[11], X1[12], X1[13], X1[14], X1[15]);
    const LAS unsigned char* vl = vbase + (4 * hi + ((lane & 15) >> 2)) * VP + (16 * ((lane >> 4) & 1) + 4 * (lane & 3)) * 2;
#pragma unroll
    for (int dt = 0; dt < NDT; ++dt) {
        const bf16x8 v0 = tr_frag(vl + 0 * 16 * VP + dt * 64, vl + (0 * 16 + 8) * VP + dt * 64);
        const bf16x8 v1 = tr_frag(vl + 1 * 16 * VP + dt * 64, vl + (1 * 16 + 8) * VP + dt * 64);
        const bf16x8 v2 = tr_frag(vl + 2 * 16 * VP + dt * 64, vl + (2 * 16 + 8) * VP + dt * 64);
        const bf16x8 v3 = tr_frag(vl + 3 * 16 * VP + dt * 64, vl + (3 * 16 + 8) * VP + dt * 64);
        O[dt] = MFMA32(pa0, v0, O[dt]); O[dt] = MFMA32(pa1, v1, O[dt]); O[dt] = MFMA32(pa2, v2, O[dt]); O[dt] = MFMA32(pa3, v3, O[dt]);
    }
}
template <int NDT>
__device__ __forceinline__ void flash_store(f32x16 (&O)[NDT], float lrun, LAS float* wsf, int lane, bf16* out, size_t ldo) {
    const int hi = lane >> 5;
    lrun += __shfl_xor(lrun, 32);
    if (hi == 0) wsf[lane] = 1.0f / lrun;
    asm volatile("s_waitcnt lgkmcnt(0)" ::: "memory");
#pragma unroll
    for (int r = 0; r < 16; ++r) { const float a = wsf[crow(r, hi)];
#pragma unroll
        for (int dt = 0; dt < NDT; ++dt) { const unsigned w = cvt_pk(O[dt][r] * a, 0.f); *at(out, (unsigned)(crow(r, hi) * (int)ldo + 32 * dt + (lane & 31)) * 2u) = (bf16)(w & 0xffffu); } }
    asm volatile("s_waitcnt lgkmcnt(0)" ::: "memory");
}

constexpr int MLA_KSLOT = 12288, MLA_VSLOT = 8192, MLA_K0 = 0, MLA_V0 = 3 * MLA_KSLOT, MLA_WS = MLA_V0 + 3 * MLA_VSLOT, MLA_OST = MLA_WS + 8 * 128, MLA_LDS = MLA_OST + 8 * 4096;
static_assert(MLA_LDS <= RING_BYTES, "MLA LDS");
__device__ __forceinline__ void glds16(const void* gsrc, unsigned lds_dst) { unsigned keep;
    asm volatile("s_mov_b32 %0, m0\n\ts_mov_b32 m0, %2\n\ts_nop 0\n\tglobal_load_lds_dwordx4 %1, off\n\ts_mov_b32 m0, %0" : "=&s"(keep) : "v"(gsrc), "s"(lds_dst) : "memory"); }
#define MLA_WAIT_BAR(N) asm volatile("s_waitcnt vmcnt(" #N ") lgkmcnt(0)\n\ts_barrier" ::: "memory")
__device__ __forceinline__ void mla_unit(const Frame& F, int b, int h, int qb, const bf16* QKV, const bf16* KR, bf16* Y) {
    int tid = F.tid; asm volatile("" : "+v"(tid));
    const int lane = tid & 63, wid = F.wave, r32 = lane & 31, hi = lane >> 5;
    const LAS unsigned char* lds = F.lds;
    const unsigned lds0 = (unsigned)(uintptr_t)F.lds;
    LAS float* wsf = (LAS float*)(F.lds + MLA_WS) + wid * 32;
    const size_t rb = (size_t)b * SEQ; const int q0 = qb * 256;
    const int qrow = q0 + 32 * wid + r32;
    const int NT = (q0 + 256) / 64;
    const int tmax = q0 / 64 + (wid >> 1);
    const bf16* ksrc = at(QKV + rb * NUP + 768 + h * 128 + wid * 8, (unsigned)(lane * NUP) * 2u);
    const bf16* rsrc = at(KR + rb * 32 + (wid & 3) * 8, (unsigned)(lane * 32) * 2u);
    const bf16* vsrc = at(QKV + rb * NUP + 768 + h * 128 + 64 + (wid >> 2) * 32, (unsigned)((16 * (wid & 3) + (lane >> 2)) * NUP + (lane & 3) * 8) * 2u);
    const unsigned kdst = lds0 + MLA_K0 + wid * 1024, rdst = lds0 + MLA_K0 + (8 + (wid & 3)) * 1024, vdst = lds0 + MLA_V0 + wid * 1024;
#define MLA_DMA(t, slot) do { glds16(ksrc + (size_t)(t) * 64 * NUP, (unsigned)__builtin_amdgcn_readfirstlane(kdst + (slot) * MLA_KSLOT)); \
        glds16(rsrc + (size_t)(t) * 64 * 32, (unsigned)__builtin_amdgcn_readfirstlane(rdst + (slot) * MLA_KSLOT)); \
        glds16(vsrc + (size_t)(t) * 64 * NUP, (unsigned)__builtin_amdgcn_readfirstlane(vdst + (slot) * MLA_VSLOT)); } while (0)
    MLA_DMA(0, 0); MLA_DMA(1, 1);
    bf16x8 qf[6];
#pragma unroll
    for (int s = 0; s < 6; ++s) qf[s] = *(const bf16x8*)at(QKV + (rb + q0 + 32 * wid) * NUP + h * 96, (unsigned)(r32 * NUP + 16 * s + 8 * hi) * 2u);
    float mrun = -1e30f, lrun = 0.f; f32x16 O[2]; O[0] = (f32x16){}; O[1] = (f32x16){};
    const int koff = hi * 1024 + r32 * 16;
    const int voff = (4 * hi + ((lane & 15) >> 2)) * 64 + (16 * ((lane >> 4) & 1) + 4 * (lane & 3)) * 2;
    int slot = 0;
    for (int t = 0; t < NT; ++t) {
        if (t + 1 < NT) MLA_WAIT_BAR(3); else MLA_WAIT_BAR(0);
        if (t + 2 < NT) { const int s2 = slot == 0 ? 2 : slot - 1; MLA_DMA(t + 2, s2); }
        if (t <= tmax) {
            const LAS unsigned char* kt = lds + MLA_K0 + slot * MLA_KSLOT + koff;
            f32x16 X0 = (f32x16){}, X1 = (f32x16){};
#pragma unroll
            for (int s = 0; s < 6; ++s) { const bf16x8 k0 = *(const LAS bf16x8*)(kt + s * 2048), k1 = *(const LAS bf16x8*)(kt + s * 2048 + 512); X0 = MFMA32(k0, qf[s], X0); X1 = MFMA32(k1, qf[s], X1); }
            if (64 * t + 63 > q0 + 32 * wid) {
#pragma unroll
                for (int r = 0; r < 16; ++r) { const int kk = 64 * t + crow(r, hi); if (kk > qrow) X0[r] = -INFINITY; if (kk + 32 > qrow) X1[r] = -INFINITY; }
            }
            float rm = X0[0];
#pragma unroll
            for (int r = 1; r < 16; ++r) rm = fmaxf(rm, X0[r]);
#pragma unroll
            for (int r = 0; r < 16; ++r) rm = fmaxf(rm, X1[r]);
            rm = fmaxf(rm, __shfl_xor(rm, 32));
            if (__any(rm > mrun + 8.0f)) {
                const float mnew = fmaxf(mrun, rm), alpha = __builtin_amdgcn_exp2f(mrun - mnew);
                mrun = mnew; lrun *= alpha;
                if (hi == 0) wsf[lane] = alpha;
                asm volatile("s_waitcnt lgkmcnt(0)" ::: "memory");
#pragma unroll
                for (int r = 0; r < 16; ++r) { const float a = wsf[crow(r, hi)]; O[0][r] *= a; O[1][r] *= a; }
                asm volatile("s_waitcnt lgkmcnt(0)" ::: "memory");
            }
            float ps = 0.f;
#pragma unroll
            for (int r = 0; r < 16; ++r) { X0[r] = __builtin_amdgcn_exp2f(X0[r] - mrun); X1[r] = __builtin_amdgcn_exp2f(X1[r] - mrun); ps += X0[r] + X1[r]; }
            lrun += ps;
            const bf16x8 pa0 = pack8(X0[0], X0[1], X0[2], X0[3], X0[4], X0[5], X0[6], X0[7]), pa1 = pack8(X0[8], X0[9], X0[10], X0[11], X0[12], X0[13], X0[14], X0[15]);
            const bf16x8 pa2 = pack8(X1[0], X1[1], X1[2], X1[3], X1[4], X1[5], X1[6], X1[7]), pa3 = pack8(X1[8], X1[9], X1[10], X1[11], X1[12], X1[13], X1[14], X1[15]);
            const LAS unsigned char* vl = lds + MLA_V0 + slot * MLA_VSLOT + voff;
#pragma unroll
            for (int dt = 0; dt < 2; ++dt) {
                const bf16x8 v0 = tr_frag(vl + (dt * 4 + 0) * 1024, vl + (dt * 4 + 0) * 1024 + 512), v1 = tr_frag(vl + (dt * 4 + 1) * 1024, vl + (dt * 4 + 1) * 1024 + 512);
                const bf16x8 v2 = tr_frag(vl + (dt * 4 + 2) * 1024, vl + (dt * 4 + 2) * 1024 + 512), v3 = tr_frag(vl + (dt * 4 + 3) * 1024, vl + (dt * 4 + 3) * 1024 + 512);
                O[dt] = MFMA32(pa0, v0, O[dt]); O[dt] = MFMA32(pa1, v1, O[dt]); O[dt] = MFMA32(pa2, v2, O[dt]); O[dt] = MFMA32(pa3, v3, O[dt]);
            }
        }
        slot = slot == 2 ? 0 : slot + 1;
    }
    lrun += __shfl_xor(lrun, 32);
    if (hi == 0) wsf[lane] = 1.0f / lrun;
    asm volatile("s_waitcnt lgkmcnt(0)" ::: "memory");
    LAS bf16* stg = (LAS bf16*)(F.lds + MLA_OST) + wid * 2048;
#pragma unroll
    for (int r = 0; r < 16; ++r) { const float a = wsf[crow(r, hi)]; const int orow = crow(r, hi);
        stg[orow * 64 + r32] = (bf16)(cvt_pk(O[0][r] * a, 0.f) & 0xffffu); stg[orow * 64 + 32 + r32] = (bf16)(cvt_pk(O[1][r] * a, 0.f) & 0xffffu); }
    asm volatile("s_waitcnt lgkmcnt(0)" ::: "memory");
    bf16* Yw = Y + (rb + q0 + 32 * wid) * D + h * 64;
#pragma unroll
    for (int i = 0; i < 4; ++i) { const int row = i * 8 + (lane >> 3), ch = lane & 7; const u32x4 v = *(const LAS u32x4*)(stg + row * 64 + ch * 8); *(u32x4*)at(Yw, (unsigned)(row * D + ch * 8) * 2u) = v; }
    asm volatile("s_waitcnt lgkmcnt(0)\n\ts_barrier" ::: "memory");
#undef MLA_DMA
}

constexpr int RT_VP = 320;
__device__ __forceinline__ void stage_tile128(LAS unsigned char* dst, const bf16* src, size_t ld, int tid) {
#pragma unroll
    for (int i = 0; i < 4; ++i) { const int p = tid + 512 * i, row = p >> 4, ch = p & 15; *(LAS u32x4*)(dst + row * RT_VP + ch * 16) = *(const u32x4*)at(src, (unsigned)(row * (int)ld + ch * 8) * 2u); }
}
__device__ __forceinline__ void ret_kv_unit(const Frame& F, int U, const bf16* RK, const bf16* RV, float* KVT) {
    int tid = F.tid; asm volatile("" : "+v"(tid));
    const int lane = tid & 63, wid = F.wave, hi = lane >> 5;
    const int bh = U >> 5, c = U & 31, b = bh >> 2, h = bh & 3;
    const size_t t0 = (size_t)b * SEQ + c * 128;
    LAS unsigned char* kt = F.lds; LAS unsigned char* vt = F.lds + 128 * RT_VP;
    stage_tile128(kt, RK + t0 * 512 + h * 128, 512, tid); stage_tile128(vt, RV + t0 * 512 + h * 128, 512, tid);
    __syncthreads();
    const int dvb = wid >> 1, dk0 = 2 * (wid & 1);
    f32x16 acc0 = (f32x16){}, acc1 = (f32x16){};
    const int lo = (8 * hi + ((lane & 15) >> 2)) * RT_VP + (16 * ((lane >> 4) & 1) + 4 * (lane & 3)) * 2;
#pragma unroll
    for (int s = 0; s < 8; ++s) {
        const bf16x8 af = tr_frag(vt + lo + 16 * s * RT_VP + dvb * 64, vt + lo + (16 * s + 4) * RT_VP + dvb * 64);
        const bf16x8 b0 = tr_frag(kt + lo + 16 * s * RT_VP + dk0 * 64, kt + lo + (16 * s + 4) * RT_VP + dk0 * 64);
        const bf16x8 b1 = tr_frag(kt + lo + 16 * s * RT_VP + (dk0 + 1) * 64, kt + lo + (16 * s + 4) * RT_VP + (dk0 + 1) * 64);
        acc0 = MFMA32(af, b0, acc0); acc1 = MFMA32(af, b1, acc1);
    }
    float* o = KVT + (size_t)U * 16384 + (size_t)(32 * dvb) * 128 + 32 * dk0;
#pragma unroll
    for (int r = 0; r < 16; ++r) { *at(o, (unsigned)(crow(r, hi) * 128 + (lane & 31)) * 4u) = acc0[r]; *at(o, (unsigned)(crow(r, hi) * 128 + 32 + (lane & 31)) * 4u) = acc1[r]; }
    __syncthreads();
}
__device__ __forceinline__ void ret_scan(const Frame& F, float* KVT) {
    const int gt = F.vcu * 512 + F.tid, NT = F.G * 512;
    for (int i = gt; i < 16 * 16384; i += NT) {
        const int bh = i >> 14, e = i & 16383, h = bh & 3;
        const float lg = __builtin_amdgcn_logf(1.0f - __builtin_amdgcn_exp2f(-5.0f - (float)h));
        const float dec = __builtin_amdgcn_exp2f(128.0f * lg);
        const unsigned po = (unsigned)(bh * 32 * 16384 + e) * 4u; float st = 0.f;
#pragma unroll 8
        for (int c = 0; c < 32; ++c) { float* p = at(KVT, po + (unsigned)c * 65536u); const float v = *p; *p = st; st = dec * st + v; }
    }
}
__device__ __forceinline__ void ret_out_pair(const Frame& F, int pair, const bf16* RQ, const bf16* RK, const bf16* RV, const bf16* RG, const float* KVT, bf16* Y) {
    int tid = F.tid; asm volatile("" : "+v"(tid));
    const int lane = tid & 63, wid = F.wave, r32 = lane & 31, hi = lane >> 5;
    const int u = wid >> 2, ib = wid & 3, U = 2 * pair + u;
    const int bh = U >> 5, c = U & 31, b = bh >> 2, h = bh & 3;
    const size_t t0 = (size_t)b * SEQ + c * 128;
    {
        const int U0 = 2 * pair, bh0 = U0 >> 5, c0 = U0 & 31; const size_t s0 = (size_t)(bh0 >> 2) * SEQ + c0 * 128;
        stage_tile128(F.lds, RV + s0 * 512 + (bh0 & 3) * 128, 512, tid);
        const int U1 = U0 + 1, bh1 = U1 >> 5, c1 = U1 & 31; const size_t s1 = (size_t)(bh1 >> 2) * SEQ + c1 * 128;
        stage_tile128(F.lds + 128 * RT_VP, RV + s1 * 512 + (bh1 & 3) * 128, 512, tid);
    }
    __syncthreads();
    const LAS unsigned char* vt = F.lds + u * 128 * RT_VP;
    const float lg = __builtin_amdgcn_logf(1.0f - __builtin_amdgcn_exp2f(-5.0f - (float)h));
    bf16x8 qf[8];
#pragma unroll
    for (int s = 0; s < 8; ++s) qf[s] = *(const bf16x8*)at(RQ + (t0 + 32 * ib) * 512 + h * 128, (unsigned)(r32 * 512 + 16 * s + 8 * hi) * 2u);
    f32x16 acc[4]; acc[0] = (f32x16){}; acc[1] = (f32x16){}; acc[2] = (f32x16){}; acc[3] = (f32x16){};
    if (c > 0) {
        const float* pv = at(KVT + (size_t)U * 16384, (unsigned)(r32 * 128 + 8 * hi) * 4u);
#pragma unroll
        for (int s = 0; s < 8; ++s)
#pragma unroll
            for (int dt = 0; dt < 4; ++dt) { const f32x4 a = *(const f32x4*)(pv + (size_t)dt * 32 * 128 + 16 * s), bq = *(const f32x4*)(pv + (size_t)dt * 32 * 128 + 16 * s + 4);
                acc[dt] = MFMA32(qf[s], pack8(a[0], a[1], a[2], a[3], bq[0], bq[1], bq[2], bq[3]), acc[dt]); }
#pragma unroll
        for (int r = 0; r < 16; ++r) { const float sc = __builtin_amdgcn_exp2f((float)(32 * ib + crow(r, hi) + 1) * lg);
#pragma unroll
            for (int dt = 0; dt < 4; ++dt) acc[dt][r] *= sc; }
    }
    const float colsc = __builtin_amdgcn_exp2f((float)(32 * ib + r32 - 127) * lg);
    const int vlo = (4 * hi + ((lane & 15) >> 2)) * RT_VP + (16 * ((lane >> 4) & 1) + 4 * (lane & 3)) * 2;
#pragma unroll 1
    for (int jb = 0; jb <= ib; ++jb) {
        f32x16 X = (f32x16){};
        const bf16* kp = at(RK + (t0 + 32 * jb) * 512 + h * 128, (unsigned)(r32 * 512 + 8 * hi) * 2u);
#pragma unroll
        for (int s = 0; s < 8; ++s) X = MFMA32(*(const bf16x8*)(kp + 16 * s), qf[s], X);
#pragma unroll
        for (int r = 0; r < 16; ++r) { X[r] *= colsc; if (jb == ib && crow(r, hi) > r32) X[r] = 0.f; }
        const bf16x8 pa0 = pack8(X[0], X[1], X[2], X[3], X[4], X[5], X[6], X[7]), pa1 = pack8(X[8], X[9], X[10], X[11], X[12], X[13], X[14], X[15]);
        const LAS unsigned char* vb = vt + vlo + 32 * jb * RT_VP;
#pragma unroll
        for (int dt = 0; dt < 4; ++dt) {
            const bf16x8 v0 = tr_frag(vb + dt * 64, vb + 8 * RT_VP + dt * 64), v1 = tr_frag(vb + 16 * RT_VP + dt * 64, vb + 24 * RT_VP + dt * 64);
            acc[dt] = MFMA32(pa0, v0, acc[dt]); acc[dt] = MFMA32(pa1, v1, acc[dt]);
        }
    }
#pragma unroll
    for (int r = 0; r < 16; ++r) {
        float s1 = (acc[0][r] + acc[1][r]) + (acc[2][r] + acc[3][r]);
        float s2 = (acc[0][r] * acc[0][r] + acc[1][r] * acc[1][r]) + (acc[2][r] * acc[2][r] + acc[3][r] * acc[3][r]);
#pragma unroll
        for (int o = 1; o < 32; o <<= 1) { s1 += __shfl_xor(s1, o); s2 += __shfl_xor(s2, o); }
        const float mean = s1 * (1.0f / 128.0f), var = fmaxf(s2 * (1.0f / 128.0f) - mean * mean, 0.f), rstd = 1.0f / sqrtf(var + EPS);
        const int rl = crow(r, hi);
#pragma unroll
        for (int dt = 0; dt < 4; ++dt) { const float g = bf2f(*at(RG + (t0 + 32 * ib) * 512 + h * 128, (unsigned)(rl * 512 + 32 * dt + r32) * 2u));
            const unsigned w = cvt_pk((acc[dt][r] - mean) * rstd * g, 0.f); *at(Y + (t0 + 32 * ib) * D + 512 + h * 128, (unsigned)(rl * D + 32 * dt + r32) * 2u) = (bf16)(w & 0xffffu); }
    }
    __syncthreads();
}

constexpr int N_PHASES = 12;
struct Args { const void* in[21]; float* out; unsigned char* ws; int ph_lo, ph_hi, flags, li; };
__global__ void __launch_bounds__(NWAVES * 64, 2) hymba_fwd(Args args) {
    extern __shared__ __attribute__((aligned(16))) unsigned char lds_raw[];
    Frame F;
    F.lds = (LAS unsigned char*)lds_raw;
    F.tid = threadIdx.x; F.lane = F.tid & 63; F.wave = __builtin_amdgcn_readfirstlane(F.tid >> 6);
    F.G = gridDim.x; { const int bx = blockIdx.x; F.vcu = (F.G % 8 == 0) ? (bx % 8) * (F.G / 8) + bx / 8 : bx; }
    Ptrs P;
    P.x = (const float*)args.in[0]; P.mem = (const float*)args.in[1]; P.pos = (const int*)args.in[2]; P.g_mix = (const float*)args.in[3]; P.w_in = (const float*)args.in[4];
    P.g_q_lat = (const float*)args.in[5]; P.w_uq = (const float*)args.in[6]; P.g_kv_lat = (const float*)args.in[7]; P.w_ukv = (const float*)args.in[8]; P.w_out = (const float*)args.in[9];
    P.g_xattn = (const float*)args.in[10]; P.g_mem = (const float*)args.in[11]; P.w_xq = (const float*)args.in[12]; P.w_xkv = (const float*)args.in[13]; P.w_xo = (const float*)args.in[14];
    P.g_ffn = (const float*)args.in[15]; P.w_ffn_in = (const float*)args.in[16]; P.conv_w = (const float*)args.in[17]; P.conv_b = (const float*)args.in[18]; P.w_ffn_out = (const float*)args.in[19];
    P.g_final = (const float*)args.in[20]; P.out = args.out; P.ws = args.ws;
    unsigned char* ws = args.ws;
    gu32* ctl = (gu32*)(ws + WS_CTL);
    volatile LAS unsigned* MISC = (volatile LAS unsigned*)(F.lds + MISC_OFF);
    for (int u = F.tid; u < (LDS_BYTES - LDSCTL_OFF) / 4; u += NWAVES * 64) ((LAS unsigned*)(F.lds + LDSCTL_OFF))[u] = 0u;
    __syncthreads();
    XcdBarrier bar; bar.bar = (unsigned*)(ctl + CW_BAR) + args.li * XCD_BAR_WORDS; bar.x = 0; bar.st = nullptr;
    if (MK_N_LAUNCHES == 1) bar = xcd_barrier_post((unsigned*)(ctl + CW_BAR) + args.li * XCD_BAR_WORDS, MISC + 8);
    const int lo = args.ph_lo, hi_ph = args.ph_hi;
#ifndef PH_MASK
#define PH_MASK 0xFFF
#endif
#define IN(k) ((((PH_MASK) >> (k)) & 1) && lo <= (k) && (k) < hi_ph)
#define SEAM(k) do { if (IN(k) && IN((k) + 1)) xcd_barrier(bar); } while (0)

    bf16* Win = (bf16*)(ws + WS_WIN); bf16* Wup = (bf16*)(ws + WS_WUP); bf16* Wout = (bf16*)(ws + WS_WOUT); bf16* Wxq = (bf16*)(ws + WS_WXQ); bf16* Wxkv = (bf16*)(ws + WS_WXKV);
    bf16* Wxo = (bf16*)(ws + WS_WXO); bf16* Wffi = (bf16*)(ws + WS_WFFI); bf16* Wffo = (bf16*)(ws + WS_WFFO);
    float* CS = (float*)(ws + WS_CS); float* SSQL = (float*)(ws + WS_SSQL); float* SSQ1 = (float*)(ws + WS_SSQ1); float* SSQ2 = (float*)(ws + WS_SSQ2);
    bf16* MEMN = (bf16*)(ws + WS_MEMN); bf16* KH = (bf16*)(ws + WS_KH); bf16* VTH = (bf16*)(ws + WS_VTH); bf16* PX = (bf16*)(ws + WS_PX); float* SUMP = (float*)(ws + WS_SUMP);
    bf16* XN = (bf16*)(ws + WS_A); bf16* Y = (bf16*)(ws + WS_A); bf16* XB2 = (bf16*)(ws + WS_A);
    bf16* LAT = (bf16*)(ws + WS_LAT); bf16* KR = (bf16*)(ws + WS_KR); bf16* RQ = (bf16*)(ws + WS_RQ); bf16* RK = (bf16*)(ws + WS_RK); bf16* RV = (bf16*)(ws + WS_RV); bf16* RG = (bf16*)(ws + WS_RG);
    bf16* QKV = (bf16*)(ws + WS_C); float* KVT = (float*)(ws + WS_KVT);
    bf16* XB1 = (bf16*)(ws + WS_XB1); bf16* HB = (bf16*)(ws + WS_H); bf16* QX = (bf16*)(ws + WS_QX); bf16* OX = (bf16*)(ws + WS_OX);
    const int bx = (int)blockIdx.x;

    if (IN(0)) { p0_prologue(F, P); }
    SEAM(0);
    if (IN(1)) {
        pg8::Gemm g{XN, Win, D, 64, 0, 0}; pg8::StaticOrder S; S.init(M / 256, NPROJ / 256, F.G, bx);
        EpiProj E{LAT, KR, RQ, RK, RV, RG, SSQL, CS};
        pg8::gemm_phase(F.lds, g, S, E);
    }
    SEAM(1);
    if (IN(2)) {
        { pg8::Gemm g{LAT, Wup, NLAT, 64, 0, 0}; pg8::StaticOrder S; S.init(M / 256, NUP / 256, F.G, bx); EpiUp E{QKV, SSQL, CS}; pg8::gemm_phase(F.lds, g, S, E); }
        { pg8::Gemm g{MEMN, Wxkv, D, 64, 0, 0}; pg8::StaticOrder S; S.init(4, 4, F.G, (bx + 64) % F.G); EpiTile E{KH, 4, 1, nullptr, 1.0f}; pg8::gemm_phase(F.lds, g, S, E); }
        { pg8::Gemm g{Wxkv + (size_t)1024 * D, MEMN, D, 64, 0, 0}; pg8::StaticOrder S; S.init(4, 4, F.G, (bx + 48) % F.G); EpiTile E{VTH, 1, 4, nullptr, 1.0f}; pg8::gemm_phase(F.lds, g, S, E); }
        __syncthreads();
        for (int U = F.vcu; U < 512; U += F.G) ret_kv_unit(F, U, RK, RV, KVT);
    }
    SEAM(2);
    if (IN(3)) {
        if (!(args.flags & 1)) ret_scan(F, KVT);
        for (int v = F.vcu; v < 256; v += F.G) { const int bh = v >> 3, s = v & 7;
            mla_unit(F, bh >> 3, bh & 7, 15 - s, QKV, KR, Y); mla_unit(F, bh >> 3, bh & 7, s, QKV, KR, Y); }
    }
    SEAM(3);
    if (IN(4)) { for (int p = F.vcu; p < 256; p += F.G) ret_out_pair(F, p, RQ, RK, RV, RG, KVT, Y); }
    SEAM(4);
    if (IN(5)) { pg8::Gemm g{Y, Wout, D, 64, 0, 0}; pg8::StaticOrder S; S.init(M / 256, 4, F.G, bx); EpiRes E{P.x, P.out, XB1, SSQ1}; pg8::gemm_phase(F.lds, g, S, E); }
    SEAM(5);
    if (IN(6)) {
        { pg8::Gemm g{XB1, Wxq, D, 64, 0, 0}; pg8::StaticOrder S; S.init(M / 256, 4, F.G, bx); EpiTile E{QX, 1, M / 256, SSQ1, C2_X}; pg8::gemm_phase(F.lds, g, S, E); }
        { pg8::Gemm g{QX, KH, 256, 64, M / 256, 4}; pg8::StaticOrder S; S.init(M / 256, 4, F.G, bx); EpiSoftmax E{PX, SUMP}; pg8::gemm_phase(F.lds, g, S, E); }
        { pg8::Gemm g{PX, VTH, 256, 64, M / 256, 4}; pg8::StaticOrder S; S.init(M / 256, 4, F.G, bx); EpiPV E{OX, SUMP}; pg8::gemm_phase(F.lds, g, S, E); }
    }
    SEAM(6);
    if (IN(8)) { pg8::Gemm g{OX, Wxo, D, 64, 0, 0}; pg8::StaticOrder S; S.init(M / 256, 4, F.G, bx); EpiRes E{P.out, P.out, XB2, SSQ2}; pg8::gemm_phase(F.lds, g, S, E); }
    SEAM(8);
    if (IN(9)) { pg8::Gemm g{XB2 - 2 * D, Wffi, D, FF_BLK, 0, 0}; pg8::StaticOrder S; S.init(FF_NM, NFF / 256, F.G, bx); EpiFfn E{HB, SSQ2, P.conv_w, P.conv_b}; pg8::gemm_phase(F.lds, g, S, E); }
    SEAM(9);
    if (IN(10)) { pg8::Gemm g{HB, Wffo, DFF, 64, 0, 0}; pg8::StaticOrder S; S.init(M / 256, 4, F.G, bx); EpiRes E{P.out, P.out, nullptr, nullptr}; pg8::gemm_phase(F.lds, g, S, E); }
    SEAM(10);
    if (IN(11)) {
        const int gw = F.vcu * NWAVES + F.wave, NGW = F.G * NWAVES, lane = F.lane;
        for (int m = gw; m < M; m += NGW) {
            f32x4* xr = (f32x4*)(P.out + (size_t)m * D) + lane; f32x4 v[4]; float s = 0.f;
#pragma unroll
            for (int j = 0; j < 4; ++j) { v[j] = xr[64 * j]; s += (v[j][0] * v[j][0] + v[j][1] * v[j][1]) + (v[j][2] * v[j][2] + v[j][3] * v[j][3]); }
            const float inv = 1.0f / sqrtf(wave_sum(s) * (1.0f / D) + EPS);
#pragma unroll
            for (int j = 0; j < 4; ++j) xr[64 * j] = v[j] * inv * ((const f32x4*)P.g_final)[lane + 64 * j];
        }
    }
#undef IN
#undef SEAM
}

extern "C" void kernel_launch(void* const* d_in, const int* in_sizes, int n_in, void* d_out, int out_size, void* d_ws, size_t ws_size, hipStream_t stream) {
    static int grid = 0;
    if (grid == 0) {
        int dev = 0, cus = 0;
        if (n_in != 21 || out_size != M * D || ws_size < WS_END) { fprintf(stderr, "kernel_launch: unexpected problem (n_in %d, out %d, ws %zu); nothing launched\n", n_in, out_size, ws_size); grid = -1; return; }
        if (hipGetDevice(&dev) != hipSuccess || hipDeviceGetAttribute(&cus, hipDeviceAttributeMultiprocessorCount, dev) != hipSuccess) { grid = -1; return; }
        if (hipFuncSetAttribute((const void*)hymba_fwd, hipFuncAttributeMaxDynamicSharedMemorySize, LDS_BYTES) != hipSuccess) { fprintf(stderr, "kernel_launch: hipFuncSetAttribute failed\n"); grid = -1; return; }
        int per_cu = 0;
        if (hipOccupancyMaxActiveBlocksPerMultiprocessor(&per_cu, (const void*)hymba_fwd, NWAVES * 64, LDS_BYTES) != hipSuccess || per_cu < 1) fprintf(stderr, "kernel_launch: occupancy query says %d blocks per CU\n", per_cu);
        (void)hipGetLastError();
        grid = cus;
    }
    if (grid < 0) return;
    if (hipMemsetAsync((char*)d_ws + WS_CTL, 0, CTL_ZERO_BYTES, stream) != hipSuccess) return;
    Args a{};
    for (int i = 0; i < 21; ++i) a.in[i] = d_in[i];
    a.out = (float*)d_out; a.ws = (unsigned char*)d_ws;
#ifdef PROBE_PHASE
    a.ph_lo = 0; a.ph_hi = PROBE_PHASE + 1; hipLaunchKernelGGL(hymba_fwd, dim3(grid), dim3(NWAVES * 64), LDS_BYTES, stream, a);
    a.ph_lo = PROBE_PHASE; a.ph_hi = PROBE_PHASE + 1; a.flags = 1; a.li = 1; hipLaunchKernelGGL(hymba_fwd, dim3(grid), dim3(NWAVES * 64), LDS_BYTES, stream, a);
    a.ph_lo = PROBE_PHASE + 1; a.ph_hi = N_PHASES; a.flags = 0; a.li = 2; hipLaunchKernelGGL(hymba_fwd, dim3(grid), dim3(NWAVES * 64), LDS_BYTES, stream, a);
#else
    if (MK_N_LAUNCHES == 1) { a.ph_lo = 0; a.ph_hi = N_PHASES; hipLaunchKernelGGL(hymba_fwd, dim3(grid), dim3(NWAVES * 64), LDS_BYTES, stream, a); }
#endif
#ifndef PROBE_PHASE
    else for (int p = 0; p < N_PHASES; ++p) { a.ph_lo = p; a.ph_hi = p + 1; hipLaunchKernelGGL(hymba_fwd, dim3(grid), dim3(NWAVES * 64), LDS_BYTES, stream, a); }
#endif
}
```

```cpp
#include <hip/hip_runtime.h>
#include <cstdio>
#include <cstdint>
#include <cmath>

#ifndef MK_N_LAUNCHES
#define MK_N_LAUNCHES 1
#endif

typedef unsigned short bf16;
typedef short bf16x8 __attribute__((ext_vector_type(8)));
typedef short s16x4 __attribute__((ext_vector_type(4)));
typedef float f32x4 __attribute__((ext_vector_type(4)));
typedef float f32x2 __attribute__((ext_vector_type(2)));
typedef float f32x16 __attribute__((ext_vector_type(16)));
typedef unsigned u32x4 __attribute__((ext_vector_type(4)));
typedef unsigned u32x2 __attribute__((ext_vector_type(2)));
#define LAS __attribute__((address_space(3)))
#define GAS __attribute__((address_space(1)))
typedef GAS unsigned gu32;

constexpr int NB = 4, SEQ = 4096, D = 1024, M = NB * SEQ;
constexpr int NPROJ = 2560;
constexpr int NLAT = 384;
constexpr int NUP = 1792;
constexpr int DFF = 2816, NFF = 2 * DFF;
constexpr float EPS = 1e-6f;
constexpr float LOG2E = 1.4426950408889634f;
constexpr float C2_MLA = 0.10206207261596575f * LOG2E;
constexpr float C2_X = 0.0625f * LOG2E;
constexpr float RET_KSCALE = 0.08838834764831845f;
constexpr int FF_BLK = 62, FF_TROWS = 4 * FF_BLK, FF_NM = (M + FF_TROWS - 1) / FF_TROWS;

constexpr size_t MiB = 1u << 20;
constexpr size_t WS_CTL = 0, CTL_ZERO_BYTES = 1 * MiB;
constexpr size_t WS_WIN = 1 * MiB;
constexpr size_t WS_WUP = 6 * MiB;
constexpr size_t WS_WOUT = 8 * MiB, WS_WXQ = 10 * MiB, WS_WXKV = 12 * MiB, WS_WXO = 16 * MiB;
constexpr size_t WS_WFFI = 18 * MiB;
constexpr size_t WS_WFFO = 29 * MiB;
constexpr size_t WS_CS = 35 * MiB;
constexpr size_t WS_SSQL = 43 * MiB;
constexpr size_t WS_SSQ1 = 44 * MiB, WS_SSQ2 = 45 * MiB;
constexpr size_t WS_MEMN = 46 * MiB, WS_MKV = 48 * MiB;
constexpr size_t WS_A = 52 * MiB;
constexpr size_t WS_B = 84 * MiB;
constexpr size_t WS_LAT = WS_B, WS_KR = WS_B + 12 * MiB, WS_RQ = WS_B + 13 * MiB, WS_RK = WS_B + 29 * MiB, WS_RV = WS_B + 45 * MiB, WS_RG = WS_B + 61 * MiB;
constexpr size_t WS_C = 161 * MiB;
constexpr size_t WS_KVT = 217 * MiB;
constexpr size_t WS_XB1 = WS_B, WS_H = WS_B, WS_QX = 172 * MiB, WS_PX = 204 * MiB, WS_OX = 116 * MiB;
constexpr size_t WS_SUMP = 249 * MiB;
constexpr size_t WS_KH = WS_MKV, WS_VTH = WS_MKV + 2 * MiB;
constexpr size_t WS_END = 256 * MiB;
static_assert(WS_KVT + 32 * MiB <= WS_END && WS_PX + 32 * MiB <= WS_END && WS_SUMP + MiB <= WS_END && WS_H + (size_t)M * DFF * 2 <= WS_QX, "d_ws map");
constexpr int CW_TMO = 0, CW_BAR = 4096;

constexpr int RING_BYTES = 131072, LDSCTL_OFF = RING_BYTES, MISC_OFF = LDSCTL_OFF + 320, EPI_LDS_OFF = LDSCTL_OFF + 1024  , LDS_BYTES = 147456;

#define RLX_AGENT __ATOMIC_RELAXED, __HIP_MEMORY_SCOPE_AGENT
typedef __bf16 bf16x2_t __attribute__((ext_vector_type(2)));
__device__ __forceinline__ unsigned cvt_pk(float lo, float hi) { const f32x2 v = {lo, hi}; const bf16x2_t b = __builtin_convertvector(v, bf16x2_t); return __builtin_bit_cast(unsigned, b); }
__device__ __forceinline__ float bf2f(unsigned short b) { return __uint_as_float((unsigned)b << 16); }
__device__ __forceinline__ float wave_sum(float v) {
#pragma unroll
    for (int o = 1; o < 64; o <<= 1) v += __shfl_xor(v, o);
    return v;
}
__device__ __forceinline__ float silu_f(float x) { return x * __builtin_amdgcn_rcpf(1.0f + __builtin_amdgcn_exp2f(-x * LOG2E)); }
__device__ __forceinline__ int crow(int r, int hi) { return (r & 3) + 8 * (r >> 2) + 4 * hi; }
__device__ __forceinline__ bf16x8 pack8(float a0, float a1, float a2, float a3, float a4, float a5, float a6, float a7) {
    u32x4 w; w.x = cvt_pk(a0, a1); w.y = cvt_pk(a2, a3); w.z = cvt_pk(a4, a5); w.w = cvt_pk(a6, a7); return __builtin_bit_cast(bf16x8, w);
}
typedef short v4i16_t __attribute__((ext_vector_type(4)));
__device__ __forceinline__ s16x4 tr_read(const LAS unsigned char* p) { return __builtin_bit_cast(s16x4, __builtin_amdgcn_ds_read_tr16_b64_v4i16((LAS v4i16_t*)p)); }
__device__ __forceinline__ bf16x8 tr_frag(const LAS unsigned char* p0, const LAS unsigned char* p1) {
    const s16x4 lo = tr_read(p0), hi = tr_read(p1);
    return (bf16x8){lo[0], lo[1], lo[2], lo[3], hi[0], hi[1], hi[2], hi[3]};
}
template <class T> __device__ __forceinline__ T* at(T* base, unsigned byte_off) { return (T*)((char*)base + byte_off); }
template <class T> __device__ __forceinline__ const T* at(const T* base, unsigned byte_off) { return (const T*)((const char*)base + byte_off); }
#define MFMA32(a, b, c) __builtin_amdgcn_mfma_f32_32x32x16_bf16((a), (b), (c), 0, 0, 0)

namespace pg8 {
constexpr int BM = 256, BK = 64, HALF = 128, HTB = HALF * BK * 2, STAGE_BYTES = 8 * HTB, NXCD = 8, WGM = 8;
__host__ __device__ __forceinline__ int lds_byte(int r, int c) { const int st = (r >> 4) * 2 + (c >> 5), rr = r & 15, cc = c & 31, ob = rr * 64 + cc * 2; return st * 1024 + (ob ^ (((ob >> 9) & 1) << 5)); }
__host__ __device__ __forceinline__ void stage_rc(int b, int& R, int& C) { const int st = b / 1024, sb = b % 1024, swz = sb ^ (((sb >> 9) & 1) << 5); R = (st >> 1) * 16 + swz / 64; C = (st & 1) * 32 + (swz % 64) / 2; }
__host__ __device__ __forceinline__ int perm32(int rho) { const int n = rho >> 4, i = rho & 15; return 8 * (i >> 2) + 4 * n + (i & 3); }

struct Unit { int pm, pn; };
struct Gemm { const bf16* A; const bf16* Bt; int K; int a_blk; int a_pn; int b_pm; };

struct StaticOrder {
    int nM, nN, nwg, G, c;
    __device__ void init(int nM_, int nN_, int G_, int c_) { nM = nM_; nN = nN_; nwg = nM * nN; G = G_; c = c_; }
    __device__ bool next(int i, Unit& u) const {
        const long L = (long)i * G + c; if (L >= nwg) return false;
        int wgid = (int)L; { const int q = nwg / NXCD, r = nwg % NXCD, xcd = wgid % NXCD, off = wgid / NXCD; wgid = (xcd < r ? xcd * (q + 1) : r * (q + 1) + (xcd - r) * q) + off; }
        const int nig = WGM * nN, gid = wgid / nig, fm = gid * WGM, gsz = (nM - fm) < WGM ? (nM - fm) : WGM;
        u.pm = fm + ((wgid % nig) % gsz); u.pn = (wgid % nig) / gsz; return true;
    }
};

template <class Epi>
__device__ __forceinline__ void gemm_phase(LAS unsigned char* lds, const Gemm g, const StaticOrder& S, const Epi& E) {
    int tid = threadIdx.x; asm volatile("" : "+v"(tid));
    const int wid = __builtin_amdgcn_readfirstlane(tid >> 6), lane = tid & 63, wr = wid >> 2, wc = wid & 3, fr = lane & 15, fq = lane >> 4;
    const int K = g.K, nt = K / BK;
    unsigned voffA[2], voffB[2];
#pragma unroll
    for (int i = 0; i < 2; ++i) { int R, C; stage_rc(tid * 16 + i * 8192, R, C); const int Rb = (R & ~31) + perm32(R & 31); const int Ra = (R >> 6) * g.a_blk + (R & 63);
        voffA[i] = (unsigned)(Ra * K + C) * 2u; voffB[i] = (unsigned)(Rb * K + C) * 2u; }
    const size_t kstep = (size_t)(BK * 2);
    const size_t hstepA = (size_t)2 * g.a_blk * K * 2, tstepA = 2 * hstepA;
    const size_t hstepB = (size_t)HALF * K * 2, tstepB = 2 * hstepB;
    const unsigned ldsw = (unsigned)wid * 1024u;
    const int aoff = lds_byte(wr * 64 + fr, fq * 8), boff = lds_byte(wc * 32 + fr, fq * 8);
#define PG8_SA(b, h) (((b) * 2 + (h)) * HTB)
#define PG8_SB(b, h) ((4 + (b) * 2 + (h)) * HTB)
#define PG8_STAGE(bufoff, gbase, voff) do { _Pragma("unroll") for (int _i = 0; _i < 2; ++_i) \
        __builtin_amdgcn_global_load_lds((const unsigned*)((const char*)(gbase) + (voff)[_i]), (LAS unsigned*)(lds + (bufoff) + ldsw + _i * 8192), 16, 0, 0); } while (0)
#define PG8_LDA(dst, b, h) do { _Pragma("unroll") for (int m = 0; m < 4; ++m) _Pragma("unroll") for (int k = 0; k < 2; ++k) dst[m][k] = *(const LAS bf16x8*)(lds + PG8_SA(b, h) + aoff + m * 2048 + k * 1024); } while (0)
#define PG8_LDB(dst, b, h) do { _Pragma("unroll") for (int n = 0; n < 2; ++n) _Pragma("unroll") for (int k = 0; k < 2; ++k) dst[n][k] = *(const LAS bf16x8*)(lds + PG8_SB(b, h) + boff + n * 2048 + k * 1024); } while (0)
#define PG8_MMA(ai, bj, At, Bt) do { __builtin_amdgcn_s_setprio(1); _Pragma("unroll") for (int m = 0; m < 4; ++m) _Pragma("unroll") for (int n = 0; n < 2; ++n) _Pragma("unroll") for (int k = 0; k < 2; ++k) \
        acc[ai][bj][m][n] = __builtin_amdgcn_mfma_f32_16x16x32_bf16(Bt[n][k], At[m][k], acc[ai][bj][m][n], 0, 0, 0); __builtin_amdgcn_s_setprio(0); } while (0)
#define PG8_WAIT_V(n) asm volatile("s_waitcnt vmcnt(" #n ")" ::: "memory")
#define PG8_WAIT_L(n) asm volatile("s_waitcnt lgkmcnt(" #n ")" ::: "memory")
#define PG8_BAR __builtin_amdgcn_s_barrier()
#define PG8_SCHED __builtin_amdgcn_sched_barrier(0)
    Unit cur, nxt; int ui = 0;
    if (!S.next(0, cur)) return;
    f32x4 acc[2][2][4][2];
#pragma unroll
    for (int a = 0; a < 2; ++a)
#pragma unroll
        for (int b = 0; b < 2; ++b)
#pragma unroll
            for (int m = 0; m < 4; ++m)
#pragma unroll
                for (int n = 0; n < 2; ++n) acc[a][b][m][n] = (f32x4){0.f, 0.f, 0.f, 0.f};
    bf16x8 At[4][2], B0[2][2], B1[2][2];
    const char* cA = (const char*)g.A + (size_t)(cur.pm + cur.pn * g.a_pn) * tstepA; const char* cB = (const char*)g.Bt + (size_t)(cur.pn + (cur.pm >> 4) * g.b_pm) * tstepB;
    PG8_STAGE(PG8_SB(0, 0), cB, voffB); PG8_STAGE(PG8_SB(0, 1), cB + hstepB, voffB); PG8_STAGE(PG8_SA(0, 0), cA, voffA); PG8_STAGE(PG8_SA(0, 1), cA + hstepA, voffA);
    if (wr == 1) PG8_BAR;
    PG8_WAIT_V(2); PG8_BAR;
    PG8_STAGE(PG8_SB(1, 0), cB + kstep, voffB); PG8_STAGE(PG8_SA(1, 0), cA + kstep, voffA); PG8_STAGE(PG8_SB(1, 1), cB + hstepB + kstep, voffB);
    PG8_WAIT_V(6); PG8_BAR;
    for (;;) {
        const bool has_next = S.next(ui + 1, nxt);
        const char* nA = has_next ? (const char*)g.A + (size_t)(nxt.pm + nxt.pn * g.a_pn) * tstepA : cA; const char* nB = has_next ? (const char*)g.Bt + (size_t)(nxt.pn + (nxt.pm >> 4) * g.b_pm) * tstepB : cB;
#pragma unroll 1
        for (int t = 0; t < nt; t += 2) {
            const bool last = (t == nt - 2);
            const char* a1 = cA + (size_t)(t + 1) * kstep;
            const char* a2 = last ? nA : cA + (size_t)(t + 2) * kstep; const char* b2 = last ? nB : cB + (size_t)(t + 2) * kstep;
            const char* a3 = a2 + kstep; const char* b3 = b2 + kstep;
            PG8_LDB(B0, 0, 0); PG8_LDB(B1, 0, 1); PG8_SCHED; PG8_LDA(At, 0, 0); PG8_STAGE(PG8_SA(1, 1), a1 + hstepA, voffA);
            PG8_WAIT_V(8); PG8_WAIT_L(0); PG8_BAR; PG8_MMA(0, 0, At, B0); PG8_MMA(0, 1, At, B1); PG8_BAR; PG8_SCHED;
            PG8_LDA(At, 0, 1); PG8_STAGE(PG8_SB(0, 0), b2, voffB); PG8_STAGE(PG8_SB(0, 1), b2 + hstepB, voffB); PG8_STAGE(PG8_SA(0, 0), a2, voffA);
            PG8_WAIT_V(8); PG8_WAIT_L(0); PG8_BAR; PG8_MMA(1, 0, At, B0); PG8_MMA(1, 1, At, B1); PG8_BAR; PG8_SCHED;
            PG8_LDB(B0, 1, 0); PG8_LDB(B1, 1, 1); PG8_SCHED; PG8_LDA(At, 1, 0); PG8_STAGE(PG8_SA(0, 1), a2 + hstepA, voffA);
            PG8_WAIT_V(8); PG8_WAIT_L(0); PG8_BAR; PG8_MMA(0, 0, At, B0); PG8_MMA(0, 1, At, B1); PG8_BAR; PG8_SCHED;
            PG8_LDA(At, 1, 1); PG8_STAGE(PG8_SB(1, 0), b3, voffB); PG8_STAGE(PG8_SB(1, 1), b3 + hstepB, voffB); PG8_STAGE(PG8_SA(1, 0), a3, voffA);
            PG8_WAIT_V(8); PG8_WAIT_L(0); PG8_BAR; PG8_MMA(1, 0, At, B0); PG8_MMA(1, 1, At, B1); PG8_BAR; PG8_SCHED;
        }
        if (wr == 0) PG8_BAR;
        E(acc, cur, wr, wc, fr, fq, lds);
        if (!has_next) break;
#pragma unroll
        for (int a = 0; a < 2; ++a)
#pragma unroll
            for (int b = 0; b < 2; ++b)
#pragma unroll
                for (int m = 0; m < 4; ++m)
#pragma unroll
                    for (int n = 0; n < 2; ++n) acc[a][b][m][n] = (f32x4){0.f, 0.f, 0.f, 0.f};
        cur = nxt; cA = nA; cB = nB; ++ui;
        if (wr == 1) PG8_BAR;
    }
    PG8_WAIT_V(0);
    PG8_BAR;
#undef PG8_SA
#undef PG8_SB
#undef PG8_STAGE
#undef PG8_LDA
#undef PG8_LDB
#undef PG8_MMA
#undef PG8_WAIT_V
#undef PG8_WAIT_L
#undef PG8_BAR
#undef PG8_SCHED
}
}

typedef f32x4 Acc[2][2][4][2];
__device__ __forceinline__ void st8bf(bf16* p, const f32x4 a, const f32x4 b) { u32x4 w; w.x = cvt_pk(a[0], a[1]); w.y = cvt_pk(a[2], a[3]); w.z = cvt_pk(b[0], b[1]); w.w = cvt_pk(b[2], b[3]); *(u32x4*)p = w; }
__device__ __forceinline__ float ssq8(const f32x4 a, const f32x4 b) { return (a[0] * a[0] + a[1] * a[1]) + (a[2] * a[2] + a[3] * a[3]) + (b[0] * b[0] + b[1] * b[1]) + (b[2] * b[2] + b[3] * b[3]); }
__device__ __forceinline__ float red_fq(float s) { s += __shfl_xor(s, 16); s += __shfl_xor(s, 32); return s; }
__device__ __forceinline__ f32x4 rot2(const f32x4 v, const f32x4 cs) { return (f32x4){v[0] * cs[0] - v[1] * cs[1], v[1] * cs[0] + v[0] * cs[1], v[2] * cs[2] - v[3] * cs[3], v[3] * cs[2] + v[2] * cs[3]}; }

struct EpiProj {
    bf16 *LAT, *KR, *RQ, *RK, *RV, *RG; float* SSQL; const float* CS;
    __device__ __forceinline__ void operator()(const Acc& acc, const pg8::Unit& u, int wr, int wc, int fr, int fq, LAS unsigned char*) const {
        const int pn = u.pn;
#pragma unroll
        for (int ai = 0; ai < 2; ++ai)
#pragma unroll
            for (int m = 0; m < 4; ++m) {
                const int row = u.pm * 256 + ai * 128 + wr * 64 + m * 16 + fr;
                const int cw = 32 * wc + 8 * fq;
                if (pn == 0) {
                    float s = 0.f;
#pragma unroll
                    for (int bj = 0; bj < 2; ++bj) { st8bf(at(LAT, (unsigned)(row * NLAT + bj * 128 + cw) * 2u), acc[ai][bj][m][0], acc[ai][bj][m][1]); s += ssq8(acc[ai][bj][m][0], acc[ai][bj][m][1]); }
                    s = red_fq(s); if (fq == 0) *at(SSQL, (unsigned)(row * 8 + wc) * 4u) = s;
                } else if (pn == 1) {
                    st8bf(at(LAT, (unsigned)(row * NLAT + 256 + cw) * 2u), acc[ai][0][m][0], acc[ai][0][m][1]);
                    float s = red_fq(ssq8(acc[ai][0][m][0], acc[ai][0][m][1])); if (fq == 0) *at(SSQL, (unsigned)(row * 8 + 4 + wc) * 4u) = s;
                    if (wc == 0) {
                        const float* cs = at(CS, (unsigned)row * 512u);
                        f32x4 o[2];
#pragma unroll
                        for (int n = 0; n < 2; ++n) { const int i0 = 4 * fq + 2 * n; const f32x2 a = *(const f32x2*)(cs + 8 * i0), b = *(const f32x2*)(cs + 8 * i0 + 8);
                            o[n] = rot2(acc[ai][1][m][n], (f32x4){a[0], a[1], b[0], b[1]}); }
                        st8bf(at(KR, (unsigned)(row * 32 + 8 * fq) * 2u), o[0], o[1]);
                    }
                } else if (pn < 6) {
                    const float* cs = at(CS, (unsigned)row * 512u);
#pragma unroll
                    for (int bj = 0; bj < 2; ++bj) { const int head = 2 * (pn & 1) + bj; f32x4 o[2];
#pragma unroll
                        for (int n = 0; n < 2; ++n) { const int i0 = (cw + 4 * n) >> 1; o[n] = rot2(acc[ai][bj][m][n], *(const f32x4*)(cs + 2 * i0)); }
                        if (pn < 4) st8bf(at(RQ, (unsigned)(row * 512 + head * 128 + cw) * 2u), o[0], o[1]);
                        else { const float lg = __builtin_amdgcn_logf(1.0f - __builtin_amdgcn_exp2f(-5.0f - (float)head));
                            const float w = RET_KSCALE * __builtin_amdgcn_exp2f((float)(127 - (row & 127)) * lg);
                            st8bf(at(RK, (unsigned)(row * 512 + head * 128 + cw) * 2u), o[0] * w, o[1] * w); } }
                } else if (pn < 8) {
#pragma unroll
                    for (int bj = 0; bj < 2; ++bj) st8bf(at(RV, (unsigned)(row * 512 + (pn & 1) * 256 + bj * 128 + cw) * 2u), acc[ai][bj][m][0], acc[ai][bj][m][1]);
                } else {
#pragma unroll
                    for (int bj = 0; bj < 2; ++bj) { f32x4 a = acc[ai][bj][m][0], b = acc[ai][bj][m][1];
#pragma unroll
                        for (int e = 0; e < 4; ++e) { a[e] = silu_f(a[e]); b[e] = silu_f(b[e]); }
                        st8bf(at(RG, (unsigned)(row * 512 + (pn & 1) * 256 + bj * 128 + cw) * 2u), a, b); }
                }
            }
    }
};

struct EpiUp {
    bf16* QKV; const float* SSQL; const float* CS;
    __device__ __forceinline__ void operator()(const Acc& acc, const pg8::Unit& u, int wr, int wc, int fr, int fq, LAS unsigned char*) const {
        const bool isq = u.pn < 3;
#pragma unroll
        for (int ai = 0; ai < 2; ++ai)
#pragma unroll
            for (int m = 0; m < 4; ++m) {
                const int row = u.pm * 256 + ai * 128 + wr * 64 + m * 16 + fr;
                const f32x4 sq = *(const f32x4*)at(SSQL, (unsigned)(row * 8 + (isq ? 0 : 4)) * 4u);
                const float inv = 1.0f / sqrtf(((sq[0] + sq[1]) + (sq[2] + sq[3])) * (isq ? 1.0f / 256.0f : 1.0f / 128.0f) + EPS);
                const float sc = isq ? inv * C2_MLA : inv;
                const float* cs = at(CS, (unsigned)row * 512u);
#pragma unroll
                for (int bj = 0; bj < 2; ++bj) { const int col = u.pn * 256 + bj * 128 + 32 * wc + 8 * fq; f32x4 o[2];
#pragma unroll
                    for (int n = 0; n < 2; ++n) { o[n] = acc[ai][bj][m][n] * sc; const int hc = (col + 4 * n) % 96;
                        if (isq && hc >= 64) { const int i0 = (hc - 64) >> 1; const f32x2 a = *(const f32x2*)(cs + 8 * i0), b = *(const f32x2*)(cs + 8 * i0 + 8); o[n] = rot2(o[n], (f32x4){a[0], a[1], b[0], b[1]}); } }
                    st8bf(at(QKV, (unsigned)(row * NUP + col) * 2u), o[0], o[1]); }
                asm volatile("" ::: "memory");
            }
    }
};

struct EpiStore {
    bf16* O; int ldc; const float* SSQ16; float scale;
    __device__ __forceinline__ void operator()(const Acc& acc, const pg8::Unit& u, int wr, int wc, int fr, int fq, LAS unsigned char*) const {
#pragma unroll
        for (int ai = 0; ai < 2; ++ai)
#pragma unroll
            for (int m = 0; m < 4; ++m) {
                const int row = u.pm * 256 + ai * 128 + wr * 64 + m * 16 + fr;
                float sc = scale;
                if (SSQ16) { const f32x4* p = (const f32x4*)at(SSQ16, (unsigned)row * 64u); const f32x4 a = p[0], b = p[1], c = p[2], d = p[3];
                    const float t = ((a[0] + a[1]) + (a[2] + a[3])) + ((b[0] + b[1]) + (b[2] + b[3])) + ((c[0] + c[1]) + (c[2] + c[3])) + ((d[0] + d[1]) + (d[2] + d[3]));
                    sc *= 1.0f / sqrtf(t * (1.0f / 1024.0f) + EPS); }
#pragma unroll
                for (int bj = 0; bj < 2; ++bj) st8bf(at(O, (unsigned)(row * ldc + u.pn * 256 + bj * 128 + 32 * wc + 8 * fq) * 2u), acc[ai][bj][m][0] * sc, acc[ai][bj][m][1] * sc);
            }
    }
};

struct EpiTile {
    bf16* O; int tm, tn; const float* SSQ16; float scale;
    __device__ __forceinline__ void operator()(const Acc& acc, const pg8::Unit& u, int wr, int wc, int fr, int fq, LAS unsigned char*) const {
        bf16* T = O + (size_t)(u.pm * tm + u.pn * tn) * 65536;
#pragma unroll
        for (int ai = 0; ai < 2; ++ai)
#pragma unroll
            for (int m = 0; m < 4; ++m) {
                const int rl = ai * 128 + wr * 64 + m * 16 + fr;
                float sc = scale;
                if (SSQ16) { const f32x4* p = (const f32x4*)at(SSQ16, (unsigned)(u.pm * 256 + rl) * 64u); const f32x4 a = p[0], b = p[1], c = p[2], d = p[3];
                    const float t = ((a[0] + a[1]) + (a[2] + a[3])) + ((b[0] + b[1]) + (b[2] + b[3])) + ((c[0] + c[1]) + (c[2] + c[3])) + ((d[0] + d[1]) + (d[2] + d[3]));
                    sc *= 1.0f / sqrtf(t * (1.0f / 1024.0f) + EPS); }
#pragma unroll
                for (int bj = 0; bj < 2; ++bj) st8bf(at(T, (unsigned)(rl * 256 + bj * 128 + 32 * wc + 8 * fq) * 2u), acc[ai][bj][m][0] * sc, acc[ai][bj][m][1] * sc);
            }
    }
};
struct EpiSoftmax {
    bf16* PX; float* SUMP;
    __device__ __forceinline__ void operator()(const Acc& acc, const pg8::Unit& u, int wr, int wc, int fr, int fq, LAS unsigned char* lds) const {
        LAS float* PM = (LAS float*)(lds + EPI_LDS_OFF);
#pragma unroll
        for (int ai = 0; ai < 2; ++ai)
#pragma unroll
            for (int m = 0; m < 4; ++m) {
                float mx = -INFINITY;
#pragma unroll
                for (int bj = 0; bj < 2; ++bj)
#pragma unroll
                    for (int n = 0; n < 2; ++n) { const f32x4 v = acc[ai][bj][m][n]; mx = fmaxf(fmaxf(mx, fmaxf(v[0], v[1])), fmaxf(v[2], v[3])); }
                mx = fmaxf(mx, __shfl_xor(mx, 16)); mx = fmaxf(mx, __shfl_xor(mx, 32));
                if (fq == 0) PM[(ai * 128 + wr * 64 + m * 16 + fr) * 4 + wc] = mx;
            }
        asm volatile("s_waitcnt lgkmcnt(0)\n\ts_barrier" ::: "memory");
        bf16* T = PX + (size_t)(u.pn * (M / 256) + u.pm) * 65536;
#pragma unroll
        for (int ai = 0; ai < 2; ++ai)
#pragma unroll
            for (int m = 0; m < 4; ++m) {
                const int rl = ai * 128 + wr * 64 + m * 16 + fr;
                const f32x4 pm4 = *(const LAS f32x4*)(PM + rl * 4);
                const float mx = fmaxf(fmaxf(pm4[0], pm4[1]), fmaxf(pm4[2], pm4[3]));
                float s = 0.f;
#pragma unroll
                for (int bj = 0; bj < 2; ++bj) { f32x4 a = acc[ai][bj][m][0], b = acc[ai][bj][m][1];
#pragma unroll
                    for (int e = 0; e < 4; ++e) { a[e] = __builtin_amdgcn_exp2f(a[e] - mx); b[e] = __builtin_amdgcn_exp2f(b[e] - mx); }
                    s += ((a[0] + a[1]) + (a[2] + a[3])) + ((b[0] + b[1]) + (b[2] + b[3]));
                    st8bf(at(T, (unsigned)(rl * 256 + bj * 128 + 32 * wc + 8 * fq) * 2u), a, b); }
                s = red_fq(s); if (fq == 0) *at(SUMP, (unsigned)((u.pm * 256 + rl) * 16 + u.pn * 4 + wc) * 4u) = s;
            }
        asm volatile("s_waitcnt lgkmcnt(0)\n\ts_barrier" ::: "memory");
    }
};
struct EpiPV {
    bf16* OX; const float* SUMP;
    __device__ __forceinline__ void operator()(const Acc& acc, const pg8::Unit& u, int wr, int wc, int fr, int fq, LAS unsigned char*) const {
#pragma unroll
        for (int ai = 0; ai < 2; ++ai)
#pragma unroll
            for (int m = 0; m < 4; ++m) {
                const int row = u.pm * 256 + ai * 128 + wr * 64 + m * 16 + fr;
                const f32x4 sp = *(const f32x4*)at(SUMP, (unsigned)(row * 16 + u.pn * 4) * 4u);
                const float sc = 1.0f / ((sp[0] + sp[1]) + (sp[2] + sp[3]));
#pragma unroll
                for (int bj = 0; bj < 2; ++bj) st8bf(at(OX, (unsigned)(row * D + u.pn * 256 + bj * 128 + 32 * wc + 8 * fq) * 2u), acc[ai][bj][m][0] * sc, acc[ai][bj][m][1] * sc);
            }
    }
};

struct EpiRes {
    const float* base; float* out; bf16* XB; float* SSQ16;
    __device__ __forceinline__ void operator()(const Acc& acc, const pg8::Unit& u, int wr, int wc, int fr, int fq, LAS unsigned char*) const {
#pragma unroll
        for (int ai = 0; ai < 2; ++ai)
#pragma unroll
            for (int m = 0; m < 4; ++m) {
                const int row = u.pm * 256 + ai * 128 + wr * 64 + m * 16 + fr; float s = 0.f;
#pragma unroll
                for (int bj = 0; bj < 2; ++bj) { const unsigned off = (unsigned)(row * D + u.pn * 256 + bj * 128 + 32 * wc + 8 * fq);
                    const f32x4 a = *(const f32x4*)at(base, off * 4u) + acc[ai][bj][m][0], b = *(const f32x4*)at(base, off * 4u + 16u) + acc[ai][bj][m][1];
                    *(f32x4*)at(out, off * 4u) = a; *(f32x4*)at(out, off * 4u + 16u) = b;
                    if (XB) st8bf(at(XB, off * 2u), a, b);
                    s += ssq8(a, b); }
                if (SSQ16) { s = red_fq(s); if (fq == 0) *at(SSQ16, (unsigned)(row * 16 + u.pn * 4 + wc) * 4u) = s; }
                if (m & 1) asm volatile("" ::: "memory");
            }
    }
};

struct EpiFfn {
    bf16* H; const float* SSQ16; const float* cw; const float* cb;
    __device__ __forceinline__ void operator()(const Acc& acc, const pg8::Unit& u, int wr, int wc, int fr, int fq, LAS unsigned char*) const {
        const int lane = threadIdx.x & 63;
        const int colh = u.pn * 128 + 32 * wc + 8 * fq;
        f32x4 w0[2], w1[2], w2[2], bb[2];
#pragma unroll
        for (int n = 0; n < 2; ++n) { w0[n] = *(const f32x4*)(cw + colh + 4 * n); w1[n] = *(const f32x4*)(cw + DFF + colh + 4 * n); w2[n] = *(const f32x4*)(cw + 2 * DFF + colh + 4 * n); bb[n] = *(const f32x4*)(cb + colh + 4 * n); }
        const int src1 = (lane & 48) | ((fr + 15) & 15), src2 = (lane & 48) | ((fr + 14) & 15);
#pragma unroll
        for (int ai = 0; ai < 2; ++ai) {
            const int row0 = u.pm * FF_TROWS + (2 * ai + wr) * FF_BLK - 2;
            f32x4 gp[2] = {(f32x4){0.f, 0.f, 0.f, 0.f}, (f32x4){0.f, 0.f, 0.f, 0.f}};
#pragma unroll
            for (int m = 0; m < 4; ++m) {
                const int t = row0 + m * 16 + fr;
                const int tc = t < 0 ? 0 : (t >= M ? M - 1 : t);
                const f32x4* p = (const f32x4*)at(SSQ16, (unsigned)tc * 64u); const f32x4 a = p[0], b = p[1], c = p[2], d = p[3];
                const float tt = ((a[0] + a[1]) + (a[2] + a[3])) + ((b[0] + b[1]) + (b[2] + b[3])) + ((c[0] + c[1]) + (c[2] + c[3])) + ((d[0] + d[1]) + (d[2] + d[3]));
                const float inv = 1.0f / sqrtf(tt * (1.0f / 1024.0f) + EPS);
                const int ts = t & (SEQ - 1);
                f32x4 o[2], gc[2];
#pragma unroll
                for (int n = 0; n < 2; ++n) {
                    gc[n] = acc[ai][0][m][n] * inv;
#pragma unroll
                    for (int e = 0; e < 4; ++e) {
                        const float cur = gc[n][e], prv = gp[n][e];
                        float g1 = __shfl(fr == 15 ? prv : cur, src1), g0 = __shfl(fr >= 14 ? prv : cur, src2);
                        if (ts < 1) g1 = 0.f; if (ts < 2) g0 = 0.f;
                        const float cv = bb[n][e] + w0[n][e] * g0 + w1[n][e] * g1 + w2[n][e] * cur;
                        o[n][e] = silu_f(cv) * (acc[ai][1][m][n][e] * inv);
                    }
                    gp[n] = gc[n];
                }
                if ((m > 0 || fr >= 2) && t < M) st8bf(at(H, (unsigned)(t * DFF + colh) * 2u), o[0], o[1]);
                asm volatile("" ::: "memory");
            }
        }
    }
};

#define XB_TMO      128
#define XB_XCNT(j)  (256  + 64 * (j))
#define XB_XSUB(j)  (1280 + 64 * (j))
#define XB_XGEN(j)  (2304 + 64 * (j))
#define XB_TOP      3328
#define XB_TOPGEN   3392
#define XCD_BAR_WORDS 3456
#define XB_SPIN_CAP (1u << 18)
__device__ __forceinline__ unsigned xb_ld(unsigned* p)              { return __hip_atomic_load(p, __ATOMIC_RELAXED, __HIP_MEMORY_SCOPE_AGENT); }
__device__ __forceinline__ unsigned xb_add(unsigned* p, unsigned v) { return __hip_atomic_fetch_add(p, v, __ATOMIC_RELAXED, __HIP_MEMORY_SCOPE_AGENT); }
__device__ __forceinline__ unsigned xb_xcc_id() { return (unsigned)__builtin_amdgcn_s_getreg((3 << 11) | 20) & 0xFu; }
#define XB_SPIN(cond, bar) do { unsigned _sp = 0; while (cond) { __builtin_amdgcn_s_sleep(1); \
    if ((++_sp & 255u) == 0u) { if (xb_ld(&(bar)[XB_TMO])) break; if (_sp > XB_SPIN_CAP) { atomicAdd(&(bar)[XB_TMO], 1u); break; } } } } while (0)
struct XcdBarrier { unsigned* bar; unsigned x; volatile LAS unsigned* st; };
__device__ __forceinline__ XcdBarrier xcd_barrier_post(unsigned* bar, volatile LAS unsigned* st) {
    XcdBarrier b; b.bar = bar; b.x = xb_xcc_id(); b.st = st;
    if (threadIdx.x == 0) (void)xb_add(&bar[XB_XCNT(b.x)], 1u);
    return b;
}
__device__ __forceinline__ void xcd_barrier_complete(unsigned* bar, unsigned x, unsigned& nloc, unsigned& nx) {
    const unsigned G = gridDim.x * gridDim.y * gridDim.z;
    unsigned sum, cnt, mine, sp = 0u;
    for (;;) {
        sum = 0u; cnt = 0u; mine = 0u;
#pragma unroll
        for (unsigned j = 0; j < 16; ++j) { const unsigned c = xb_ld(&bar[XB_XCNT(j)]); sum += c; cnt += (c > 0u) ? 1u : 0u; mine = (j == x) ? c : mine; }
        if (sum == G) break;
        __builtin_amdgcn_s_sleep(1);
        if ((++sp & 255u) == 0u) { if (xb_ld(&bar[XB_TMO])) break; if (sp > XB_SPIN_CAP) { atomicAdd(&bar[XB_TMO], 1u); break; } }
    }
    nloc = mine > 0u ? mine : 1u; nx = cnt > 0u ? cnt : 1u;
}
__device__ __forceinline__ void xcd_barrier(const XcdBarrier& b) {
    asm volatile("s_waitcnt vmcnt(0)" ::: "memory");
    __syncthreads();
    if (threadIdx.x == 0) {
        unsigned* bar = b.bar;
        __builtin_amdgcn_s_waitcnt(0);
        unsigned nloc = b.st[0], nx = b.st[1];
        if (nloc == 0u) { xcd_barrier_complete(bar, b.x, nloc, nx); b.st[0] = nloc; b.st[1] = nx; }
        const unsigned old = xb_add(&bar[XB_XSUB(b.x)], 1u);
        const unsigned gen = old / nloc;
        if (old + 1u == (gen + 1u) * nloc) {
            __builtin_amdgcn_fence(__ATOMIC_RELEASE, "agent");
            asm volatile("s_waitcnt vmcnt(0)" ::: "memory");
            const unsigned og = xb_add(&bar[XB_TOP], 1u);
            const unsigned tg = og / nx;
            if (og + 1u == (tg + 1u) * nx) xb_add(&bar[XB_TOPGEN], 1u);
            else XB_SPIN(xb_ld(&bar[XB_TOPGEN]) == tg, bar);
            __builtin_amdgcn_fence(__ATOMIC_ACQUIRE, "agent");
            xb_add(&bar[XB_XGEN(b.x)], 1u);
            asm volatile("s_waitcnt vmcnt(0)" ::: "memory");
        } else {
            XB_SPIN(xb_ld(&bar[XB_XGEN(b.x)]) == gen, bar);
            __builtin_amdgcn_fence(__ATOMIC_ACQUIRE, "agent");
            asm volatile("s_waitcnt vmcnt(0)" ::: "memory");
        }
    }
    __syncthreads();
}

constexpr int NWAVES = 8;
struct Frame {
    LAS unsigned char* lds; int tid, lane, wave, vcu, G;
};

__device__ __forceinline__ int map_proj(int n) {
    if (n < 384) return n;
    if (n < 416) { const int j = n - 384; return 384 + (j >> 1) + 16 * (j & 1); }
    if (n < 512) return -1;
    if (n < 1536) { const int j = n - 512, hd = j >> 7, c = j & 127; return 416 + hd * 128 + (c >> 1) + 64 * (c & 1); }
    return n - 1536 + 1440;
}
__device__ __forceinline__ int map_uq(int n) { const int h = n / 96, c = n % 96; if (c < 64) return n; const int j = c - 64; return h * 96 + 64 + (j >> 1) + 16 * (j & 1); }
__device__ __forceinline__ int map_ffi(int n) { const int t = n >> 8, c = n & 255; return (c < 128) ? t * 128 + c : DFF + t * 128 + (c - 128); }

template <int MAP>
__device__ __forceinline__ void transpose_item(const float* W, int K, int Nsrc, int Ndst, const float* g, bf16* WT, int ldk, int koff, int row_off, LAS float* scr, int item, int lane) {
    const int nblk = Ndst / 32, kb = item / nblk, nb = item % nblk, k0 = 64 * kb, n0 = 32 * nb;
    const int nd = n0 + (lane & 31);
    const int ns = MAP == 0 ? nd : (MAP == 1 ? map_proj(nd) : (MAP == 2 ? map_uq(nd) : map_ffi(nd)));
    const float* wp = at(W + (size_t)k0 * Nsrc, (unsigned)(((lane >> 5) * Nsrc + (ns < 0 ? 0 : ns)) * 4));
    float v[32];
#pragma unroll
    for (int i = 0; i < 32; ++i) v[i] = wp[(size_t)(2 * i) * Nsrc];
    const int c = lane & 7;
    f32x4 g0 = (f32x4){1.f, 1.f, 1.f, 1.f}, g1 = g0;
    if (g) { g0 = *(const f32x4*)(g + k0 + 8 * c); g1 = *(const f32x4*)(g + k0 + 8 * c + 4); }
#pragma unroll
    for (int i = 0; i < 32; ++i) scr[(2 * i + (lane >> 5)) * 33 + (lane & 31)] = ns < 0 ? 0.f : v[i];
    asm volatile("s_waitcnt lgkmcnt(0)" ::: "memory");
#pragma unroll
    for (int j = 0; j < 4; ++j) { const int n = (lane >> 3) + 8 * j; const LAS float* s = scr + (8 * c) * 33 + n;
        u32x4 o; o.x = cvt_pk(s[0 * 33] * g0[0], s[1 * 33] * g0[1]); o.y = cvt_pk(s[2 * 33] * g0[2], s[3 * 33] * g0[3]); o.z = cvt_pk(s[4 * 33] * g1[0], s[5 * 33] * g1[1]); o.w = cvt_pk(s[6 * 33] * g1[2], s[7 * 33] * g1[3]);
        *(u32x4*)(WT + (size_t)(row_off + n0 + n) * ldk + koff + k0 + 8 * c) = o; }
    asm volatile("s_waitcnt lgkmcnt(0)" ::: "memory");
}
__device__ __forceinline__ void rms_rows2_to_bf16(const float* xa, const float* xb, const float* g, bf16* oa, bf16* ob, int lane) {
    const f32x4* pa = (const f32x4*)xa + lane; const f32x4* pb = (const f32x4*)xb + lane;
    f32x4 va[4], vb[4]; float sa = 0.f, sb = 0.f;
#pragma unroll
    for (int j = 0; j < 4; ++j) { va[j] = pa[64 * j]; vb[j] = pb[64 * j]; }
#pragma unroll
    for (int j = 0; j < 4; ++j) { sa += (va[j][0] * va[j][0] + va[j][1] * va[j][1]) + (va[j][2] * va[j][2] + va[j][3] * va[j][3]); sb += (vb[j][0] * vb[j][0] + vb[j][1] * vb[j][1]) + (vb[j][2] * vb[j][2] + vb[j][3] * vb[j][3]); }
    const float ia = 1.0f / sqrtf(wave_sum(sa) * (1.0f / D) + EPS), ib = 1.0f / sqrtf(wave_sum(sb) * (1.0f / D) + EPS);
    u32x2* qa = (u32x2*)oa + lane; u32x2* qb = (u32x2*)ob + lane;
#pragma unroll
    for (int j = 0; j < 4; ++j) { f32x4 wa = va[j] * ia, wb = vb[j] * ib; if (g) { const f32x4 gg = ((const f32x4*)g)[lane + 64 * j]; wa = wa * gg; wb = wb * gg; }
        u32x2 t; t.x = cvt_pk(wa[0], wa[1]); t.y = cvt_pk(wa[2], wa[3]); qa[64 * j] = t; t.x = cvt_pk(wb[0], wb[1]); t.y = cvt_pk(wb[2], wb[3]); qb[64 * j] = t; }
}

struct Ptrs {
    const float *x, *mem; const int* pos; const float *g_mix, *w_in, *g_q_lat, *w_uq, *g_kv_lat, *w_ukv, *w_out, *g_xattn, *g_mem, *w_xq, *w_xkv, *w_xo, *g_ffn, *w_ffn_in, *conv_w, *conv_b, *w_ffn_out, *g_final;
    float* out; unsigned char* ws;
};

__device__ __forceinline__ void p0_prologue(const Frame& F, const Ptrs& P) {
    LAS float* scr = (LAS float*)(F.lds + F.wave * 16384);
    const int gw = F.vcu * NWAVES + F.wave, NGW = F.G * NWAVES, lane = F.lane;
    unsigned char* ws = P.ws;
    bf16* Win = (bf16*)(ws + WS_WIN); bf16* Wup = (bf16*)(ws + WS_WUP);
    for (int i = gw * 64 + lane; i < 768 * 16 + 1024 * 32; i += NGW * 64) {
        if (i < 768 * 16) { const int r = i >> 4, c = i & 15; *(u32x4*)(Wup + (size_t)r * NLAT + 256 + 8 * c) = (u32x4){0u, 0u, 0u, 0u}; }
        else { const int j = i - 768 * 16, r = 768 + (j >> 5), c = j & 31; *(u32x4*)(Wup + (size_t)r * NLAT + 8 * c) = (u32x4){0u, 0u, 0u, 0u}; }
    }
    constexpr int I_IN = (D / 64) * (NPROJ / 32), I_UQ = (256 / 64) * (768 / 32), I_UKV = (128 / 64) * (1024 / 32), I_SQ = (D / 64) * (D / 32), I_XKV = (D / 64) * (2048 / 32), I_FFI = (D / 64) * (NFF / 32), I_FFO = (DFF / 64) * (D / 32);
    constexpr int NITEMS = I_IN + I_UQ + I_UKV + 3 * I_SQ + I_XKV + I_FFI + I_FFO;
    for (int it = gw; it < NITEMS; it += NGW) {
        int r = it;
        if (r < I_IN) { transpose_item<1>(P.w_in, D, 2464, NPROJ, P.g_mix, Win, D, 0, 0, scr, r, lane); continue; } r -= I_IN;
        if (r < I_UQ) { transpose_item<2>(P.w_uq, 256, 768, 768, P.g_q_lat, Wup, NLAT, 0, 0, scr, r, lane); continue; } r -= I_UQ;
        if (r < I_UKV) { transpose_item<0>(P.w_ukv, 128, 1024, 1024, P.g_kv_lat, Wup, NLAT, 256, 768, scr, r, lane); continue; } r -= I_UKV;
        if (r < I_SQ) { transpose_item<0>(P.w_out, D, D, D, nullptr, (bf16*)(ws + WS_WOUT), D, 0, 0, scr, r, lane); continue; } r -= I_SQ;
        if (r < I_SQ) { transpose_item<0>(P.w_xq, D, D, D, P.g_xattn, (bf16*)(ws + WS_WXQ), D, 0, 0, scr, r, lane); continue; } r -= I_SQ;
        if (r < I_SQ) { transpose_item<0>(P.w_xo, D, D, D, nullptr, (bf16*)(ws + WS_WXO), D, 0, 0, scr, r, lane); continue; } r -= I_SQ;
        if (r < I_XKV) { transpose_item<0>(P.w_xkv, D, 2048, 2048, nullptr, (bf16*)(ws + WS_WXKV), D, 0, 0, scr, r, lane); continue; } r -= I_XKV;
        if (r < I_FFI) { transpose_item<3>(P.w_ffn_in, D, NFF, NFF, P.g_ffn, (bf16*)(ws + WS_WFFI), D, 0, 0, scr, r, lane); continue; } r -= I_FFI;
        transpose_item<0>(P.w_ffn_out, DFF, D, D, nullptr, (bf16*)(ws + WS_WFFO), DFF, 0, 0, scr, r, lane);
    }
    bf16* XN = (bf16*)(ws + WS_A); bf16* MEMN = (bf16*)(ws + WS_MEMN); float* CS = (float*)(ws + WS_CS);
    for (int m = 2 * gw; m < M + NB * 256; m += 2 * NGW) {
        if (m < M) rms_rows2_to_bf16(P.x + (size_t)m * D, P.x + (size_t)(m + 1) * D, nullptr, XN + (size_t)m * D, XN + (size_t)(m + 1) * D, lane);
        else rms_rows2_to_bf16(P.mem + (size_t)(m - M) * D, P.mem + (size_t)(m + 1 - M) * D, P.g_mem, MEMN + (size_t)(m - M) * D, MEMN + (size_t)(m + 1 - M) * D, lane);
    }
    {   const float rev_freq = exp2f(-(float)lane * (13.287712379549449f / 64.0f)) * 0.15915494309189535f;
        for (int m = gw; m < M; m += NGW) {
            const float fr = __builtin_amdgcn_fractf((float)P.pos[m] * rev_freq);
            *(f32x2*)(CS + (size_t)m * 128 + 2 * lane) = (f32x2){__builtin_amdgcn_cosf(fr), __builtin_amdgcn_sinf(fr)};
        } }
}

template <int NDT, int VP>
__device__ __forceinline__ void flash_step(f32x16& X0, f32x16& X1, f32x16 (&O)[NDT], float& mrun, float& lrun, const LAS unsigned char* vbase, LAS float* wsf, int lane) {
    const int hi = lane >> 5;
    float rm = X0[0];
#pragma unroll
    for (int r = 1; r < 16; ++r) rm = fmaxf(rm, X0[r]);
#pragma unroll
    for (int r = 0; r < 16; ++r) rm = fmaxf(rm, X1[r]);
    rm = fmaxf(rm, __shfl_xor(rm, 32));
    const float mnew = fmaxf(mrun, rm);
    const float alpha = __builtin_amdgcn_exp2f(mrun - mnew);
    mrun = mnew;
    float ps = 0.f;
#pragma unroll
    for (int r = 0; r < 16; ++r) { X0[r] = __builtin_amdgcn_exp2f(X0[r] - mnew); X1[r] = __builtin_amdgcn_exp2f(X1[r] - mnew); ps += X0[r] + X1[r]; }
    lrun = lrun * alpha + ps;
    if (__any(alpha != 1.0f)) {
        if (hi == 0) wsf[lane] = alpha;
        asm volatile("s_waitcnt lgkmcnt(0)" ::: "memory");
#pragma unroll
        for (int r = 0; r < 16; ++r) { const float a = wsf[crow(r, hi)];
#pragma unroll
            for (int dt = 0; dt < NDT; ++dt) O[dt][r] *= a; }
        asm volatile("s_waitcnt lgkmcnt(0)" ::: "memory");
    }
    const bf16x8 pa0 = pack8(X0[0], X0[1], X0[2], X0[3], X0[4], X0[5], X0[6], X0[7]), pa1 = pack8(X0[8], X0[9], X0[10], X0[11], X0[12], X0[13], X0[14], X0[15]);
    const bf16x8 pa2 = pack8(X1[0], X1[1], X1[2], X1[3], X1[4], X1[5], X1[6], X1[7]), pa3 = pack8(X1[8], X1[9], X1[10], X1[11], X1[12], X1[13], X1[14], X1[15]);
    const LAS unsigned char* vl = vbase + (4 * hi + ((lane & 15) >> 2)) * VP + (16 * ((lane >> 4) & 1) + 4 * (lane & 3)) * 2;
#pragma unroll
    for (int dt = 0; dt < NDT; ++dt) {
        const bf16x8 v0 = tr_frag(vl + 0 * 16 * VP + dt * 64, vl + (0 * 16 + 8) * VP + dt * 64);
        const bf16x8 v1 = tr_frag(vl + 1 * 16 * VP + dt * 64, vl + (1 * 16 + 8) * VP + dt * 64);
        const bf16x8 v2 = tr_frag(vl + 2 * 16 * VP + dt * 64, vl + (2 * 16 + 8) * VP + dt * 64);
        const bf16x8 v3 = tr_frag(vl + 3 * 16 * VP + dt * 64, vl + (3 * 16 + 8) * VP + dt * 64);
        O[dt] = MFMA32(pa0, v0, O[dt]); O[dt] = MFMA32(pa1, v1, O[dt]); O[dt] = MFMA32(pa2, v2, O[dt]); O[dt] = MFMA32(pa3, v3, O[dt]);
    }
}
template <int NDT>
__device__ __forceinline__ void flash_store(f32x16 (&O)[NDT], float lrun, LAS float* wsf, int lane, bf16* out, size_t ldo) {
    const int hi = lane >> 5;
    lrun += __shfl_xor(lrun, 32);
    if (hi == 0) wsf[lane] = 1.0f / lrun;
    asm volatile("s_waitcnt lgkmcnt(0)" ::: "memory");
#pragma unroll
    for (int r = 0; r < 16; ++r) { const float a = wsf[crow(r, hi)];
#pragma unroll
        for (int dt = 0; dt < NDT; ++dt) { const unsigned w = cvt_pk(O[dt][r] * a, 0.f); *at(out, (unsigned)(crow(r, hi) * (int)ldo + 32 * dt + (lane & 31)) * 2u) = (bf16)(w & 0xffffu); } }
    asm volatile("s_waitcnt lgkmcnt(0)" ::: "memory");
}

constexpr int MLA_KSLOT = 12288, MLA_VSLOT = 8192, MLA_K0 = 0, MLA_V0 = 3 * MLA_KSLOT, MLA_WS = MLA_V0 + 3 * MLA_VSLOT, MLA_OST = MLA_WS + 8 * 128, MLA_LDS = MLA_OST + 8 * 4096;
static_assert(MLA_LDS <= RING_BYTES, "MLA LDS");
__device__ __forceinline__ void glds16(const void* gsrc, unsigned lds_dst) { unsigned keep;
    asm volatile("s_mov_b32 %0, m0\n\ts_mov_b32 m0, %2\n\ts_nop 0\n\tglobal_load_lds_dwordx4 %1, off\n\ts_mov_b32 m0, %0" : "=&s"(keep) : "v"(gsrc), "s"(lds_dst) : "memory"); }
#define MLA_WAIT_BAR(N) asm volatile("s_waitcnt vmcnt(" #N ") lgkmcnt(0)\n\ts_barrier" ::: "memory")
__device__ __forceinline__ void mla_unit(const Frame& F, int b, int h, int qb, const bf16* QKV, const bf16* KR, bf16* Y) {
    int tid = F.tid; asm volatile("" : "+v"(tid));
    const int lane = tid & 63, wid = F.wave, r32 = lane & 31, hi = lane >> 5;
    const LAS unsigned char* lds = F.lds;
    const unsigned lds0 = (unsigned)(uintptr_t)F.lds;
    LAS float* wsf = (LAS float*)(F.lds + MLA_WS) + wid * 32;
    const size_t rb = (size_t)b * SEQ; const int q0 = qb * 256;
    const int qrow = q0 + 32 * wid + r32;
    const int NT = (q0 + 256) / 64;
    const int tmax = q0 / 64 + (wid >> 1);
    const bf16* ksrc = at(QKV + rb * NUP + 768 + h * 128 + wid * 8, (unsigned)(lane * NUP) * 2u);
    const bf16* rsrc = at(KR + rb * 32 + (wid & 3) * 8, (unsigned)(lane * 32) * 2u);
    const bf16* vsrc = at(QKV + rb * NUP + 768 + h * 128 + 64 + (wid >> 2) * 32, (unsigned)((16 * (wid & 3) + (lane >> 2)) * NUP + (lane & 3) * 8) * 2u);
    const unsigned kdst = lds0 + MLA_K0 + wid * 1024, rdst = lds0 + MLA_K0 + (8 + (wid & 3)) * 1024, vdst = lds0 + MLA_V0 + wid * 1024;
#define MLA_DMA(t, slot) do { glds16(ksrc + (size_t)(t) * 64 * NUP, (unsigned)__builtin_amdgcn_readfirstlane(kdst + (slot) * MLA_KSLOT)); \
        glds16(rsrc + (size_t)(t) * 64 * 32, (unsigned)__builtin_amdgcn_readfirstlane(rdst + (slot) * MLA_KSLOT)); \
        glds16(vsrc + (size_t)(t) * 64 * NUP, (unsigned)__builtin_amdgcn_readfirstlane(vdst + (slot) * MLA_VSLOT)); } while (0)
    MLA_DMA(0, 0); MLA_DMA(1, 1);
    bf16x8 qf[6];
#pragma unroll
    for (int s = 0; s < 6; ++s) qf[s] = *(const bf16x8*)at(QKV + (rb + q0 + 32 * wid) * NUP + h * 96, (unsigned)(r32 * NUP + 16 * s + 8 * hi) * 2u);
    float mrun = -1e30f, lrun = 0.f; f32x16 O[2]; O[0] = (f32x16){}; O[1] = (f32x16){};
    const int koff = hi * 1024 + r32 * 16;
    const int voff = (4 * hi + ((lane & 15) >> 2)) * 64 + (16 * ((lane >> 4) & 1) + 4 * (lane & 3)) * 2;
    int slot = 0;
    for (int t = 0; t < NT; ++t) {
        if (t + 1 < NT) MLA_WAIT_BAR(3); else MLA_WAIT_BAR(0);
        if (t + 2 < NT) { const int s2 = slot == 0 ? 2 : slot - 1; MLA_DMA(t + 2, s2); }
        if (t <= tmax) {
            const LAS unsigned char* kt = lds + MLA_K0 + slot * MLA_KSLOT + koff;
            f32x16 X0 = (f32x16){}, X1 = (f32x16){};
#pragma unroll
            for (int s = 0; s < 6; ++s) { const bf16x8 k0 = *(const LAS bf16x8*)(kt + s * 2048), k1 = *(const LAS bf16x8*)(kt + s * 2048 + 512); X0 = MFMA32(k0, qf[s], X0); X1 = MFMA32(k1, qf[s], X1); }
            if (64 * t + 63 > q0 + 32 * wid) {
#pragma unroll
                for (int r = 0; r < 16; ++r) { const int kk = 64 * t + crow(r, hi); if (kk > qrow) X0[r] = -INFINITY; if (kk + 32 > qrow) X1[r] = -INFINITY; }
            }
            float rm = X0[0];
#pragma unroll
            for (int r = 1; r < 16; ++r) rm = fmaxf(rm, X0[r]);
#pragma unroll
            for (int r = 0; r < 16; ++r) rm = fmaxf(rm, X1[r]);
            rm = fmaxf(rm, __shfl_xor(rm, 32));
            if (__any(rm > mrun + 8.0f)) {
                const float mnew = fmaxf(mrun, rm), alpha = __builtin_amdgcn_exp2f(mrun - mnew);
                mrun = mnew; lrun *= alpha;
                if (hi == 0) wsf[lane] = alpha;
                asm volatile("s_waitcnt lgkmcnt(0)" ::: "memory");
#pragma unroll
                for (int r = 0; r < 16; ++r) { const float a = wsf[crow(r, hi)]; O[0][r] *= a; O[1][r] *= a; }
                asm volatile("s_waitcnt lgkmcnt(0)" ::: "memory");
            }
            float ps = 0.f;
#pragma unroll
            for (int r = 0; r < 16; ++r) { X0[r] = __builtin_amdgcn_exp2f(X0[r] - mrun); X1[r] = __builtin_amdgcn_exp2f(X1[r] - mrun); ps += X0[r] + X1[r]; }
            lrun += ps;
            const bf16x8 pa0 = pack8(X0[0], X0[1], X0[2], X0[3], X0[4], X0[5], X0[6], X0[7]), pa1 = pack8(X0[8], X0[9], X0[10], X0[11], X0[12], X0[13], X0[14], X0[15]);
            const bf16x8 pa2 = pack8(X1[0], X1[1], X1[2], X1[3], X1[4], X1[5], X1[6], X1[7]), pa3 = pack8(X1[8], X1[9], X1[10], X1[11], X1[12], X1[13], X1[14], X1[15]);
            const LAS unsigned char* vl = lds + MLA_V0 + slot * MLA_VSLOT + voff;
#pragma unroll
            for (int dt = 0; dt < 2; ++dt) {
                const bf16x8 v0 = tr_frag(vl + (dt * 4 + 0) * 1024, vl + (dt * 4 + 0) * 1024 + 512), v1 = tr_frag(vl + (dt * 4 + 1) * 1024, vl + (dt * 4 + 1) * 1024 + 512);
                const bf16x8 v2 = tr_frag(vl + (dt * 4 + 2) * 1024, vl + (dt * 4 + 2) * 1024 + 512), v3 = tr_frag(vl + (dt * 4 + 3) * 1024, vl + (dt * 4 + 3) * 1024 + 512);
                O[dt] = MFMA32(pa0, v0, O[dt]); O[dt] = MFMA32(pa1, v1, O[dt]); O[dt] = MFMA32(pa2, v2, O[dt]); O[dt] = MFMA32(pa3, v3, O[dt]);
            }
        }
        slot = slot == 2 ? 0 : slot + 1;
    }
    lrun += __shfl_xor(lrun, 32);
    if (hi == 0) wsf[lane] = 1.0f / lrun;
    asm volatile("s_waitcnt lgkmcnt(0)" ::: "memory");
    LAS bf16* stg = (LAS bf16*)(F.lds + MLA_OST) + wid * 2048;
#pragma unroll
    for (int r = 0; r < 16; ++r) { const float a = wsf[crow(r, hi)]; const int orow = crow(r, hi);
        stg[orow * 64 + r32] = (bf16)(cvt_pk(O[0][r] * a, 0.f) & 0xffffu); stg[orow * 64 + 32 + r32] = (bf16)(cvt_pk(O[1][r] * a, 0.f) & 0xffffu); }
    asm volatile("s_waitcnt lgkmcnt(0)" ::: "memory");
    bf16* Yw = Y + (rb + q0 + 32 * wid) * D + h * 64;
#pragma unroll
    for (int i = 0; i < 4; ++i) { const int row = i * 8 + (lane >> 3), ch = lane & 7; const u32x4 v = *(const LAS u32x4*)(stg + row * 64 + ch * 8); *(u32x4*)at(Yw, (unsigned)(row * D + ch * 8) * 2u) = v; }
    asm volatile("s_waitcnt lgkmcnt(0)\n\ts_barrier" ::: "memory");
#undef MLA_DMA
}

constexpr int RT_VP = 320;
__device__ __forceinline__ void stage_tile128(LAS unsigned char* dst, const bf16* src, size_t ld, int tid) {
#pragma unroll
    for (int i = 0; i < 4; ++i) { const int p = tid + 512 * i, row = p >> 4, ch = p & 15; *(LAS u32x4*)(dst + row * RT_VP + ch * 16) = *(const u32x4*)at(src, (unsigned)(row * (int)ld + ch * 8) * 2u); }
}
__device__ __forceinline__ void ret_kv_unit(const Frame& F, int U, const bf16* RK, const bf16* RV, float* KVT) {
    int tid = F.tid; asm volatile("" : "+v"(tid));
    const int lane = tid & 63, wid = F.wave, hi = lane >> 5;
    const int bh = U >> 5, c = U & 31, b = bh >> 2, h = bh & 3;
    const size_t t0 = (size_t)b * SEQ + c * 128;
    LAS unsigned char* kt = F.lds; LAS unsigned char* vt = F.lds + 128 * RT_VP;
    stage_tile128(kt, RK + t0 * 512 + h * 128, 512, tid); stage_tile128(vt, RV + t0 * 512 + h * 128, 512, tid);
    __syncthreads();
    const int dvb = wid >> 1, dk0 = 2 * (wid & 1);
    f32x16 acc0 = (f32x16){}, acc1 = (f32x16){};
    const int lo = (8 * hi + ((lane & 15) >> 2)) * RT_VP + (16 * ((lane >> 4) & 1) + 4 * (lane & 3)) * 2;
#pragma unroll
    for (int s = 0; s < 8; ++s) {
        const bf16x8 af = tr_frag(vt + lo + 16 * s * RT_VP + dvb * 64, vt + lo + (16 * s + 4) * RT_VP + dvb * 64);
        const bf16x8 b0 = tr_frag(kt + lo + 16 * s * RT_VP + dk0 * 64, kt + lo + (16 * s + 4) * RT_VP + dk0 * 64);
        const bf16x8 b1 = tr_frag(kt + lo + 16 * s * RT_VP + (dk0 + 1) * 64, kt + lo + (16 * s + 4) * RT_VP + (dk0 + 1) * 64);
        acc0 = MFMA32(af, b0, acc0); acc1 = MFMA32(af, b1, acc1);
    }
    float* o = KVT + (size_t)U * 16384 + (size_t)(32 * dvb) * 128 + 32 * dk0;
#pragma unroll
    for (int r = 0; r < 16; ++r) { *at(o, (unsigned)(crow(r, hi) * 128 + (lane & 31)) * 4u) = acc0[r]; *at(o, (unsigned)(crow(r, hi) * 128 + 32 + (lane & 31)) * 4u) = acc1[r]; }
    __syncthreads();
}
__device__ __forceinline__ void ret_scan(const Frame& F, float* KVT) {
    const int gt = F.vcu * 512 + F.tid, NT = F.G * 512;
    for (int i = gt; i < 16 * 16384; i += NT) {
        const int bh = i >> 14, e = i & 16383, h = bh & 3;
        const float lg = __builtin_amdgcn_logf(1.0f - __builtin_amdgcn_exp2f(-5.0f - (float)h));
        const float dec = __builtin_amdgcn_exp2f(128.0f * lg);
        const unsigned po = (unsigned)(bh * 32 * 16384 + e) * 4u; float st = 0.f;
#pragma unroll 8
        for (int c = 0; c < 32; ++c) { float* p = at(KVT, po + (unsigned)c * 65536u); const float v = *p; *p = st; st = dec * st + v; }
    }
}
__device__ __forceinline__ void ret_out_pair(const Frame& F, int pair, const bf16* RQ, const bf16* RK, const bf16* RV, const bf16* RG, const float* KVT, bf16* Y) {
    int tid = F.tid; asm volatile("" : "+v"(tid));
    const int lane = tid & 63, wid = F.wave, r32 = lane & 31, hi = lane >> 5;
    const int u = wid >> 2, ib = wid & 3, U = 2 * pair + u;
    const int bh = U >> 5, c = U & 31, b = bh >> 2, h = bh & 3;
    const size_t t0 = (size_t)b * SEQ + c * 128;
    {
        const int U0 = 2 * pair, bh0 = U0 >> 5, c0 = U0 & 31; const size_t s0 = (size_t)(bh0 >> 2) * SEQ + c0 * 128;
        stage_tile128(F.lds, RV + s0 * 512 + (bh0 & 3) * 128, 512, tid);
        const int U1 = U0 + 1, bh1 = U1 >> 5, c1 = U1 & 31; const size_t s1 = (size_t)(bh1 >> 2) * SEQ + c1 * 128;
        stage_tile128(F.lds + 128 * RT_VP, RV + s1 * 512 + (bh1 & 3) * 128, 512, tid);
    }
    __syncthreads();
    const LAS unsigned char* vt = F.lds + u * 128 * RT_VP;
    const float lg = __builtin_amdgcn_logf(1.0f - __builtin_amdgcn_exp2f(-5.0f - (float)h));
    bf16x8 qf[8];
#pragma unroll
    for (int s = 0; s < 8; ++s) qf[s] = *(const bf16x8*)at(RQ + (t0 + 32 * ib) * 512 + h * 128, (unsigned)(r32 * 512 + 16 * s + 8 * hi) * 2u);
    f32x16 acc[4]; acc[0] = (f32x16){}; acc[1] = (f32x16){}; acc[2] = (f32x16){}; acc[3] = (f32x16){};
    if (c > 0) {
        const float* pv = at(KVT + (size_t)U * 16384, (unsigned)(r32 * 128 + 8 * hi) * 4u);
#pragma unroll
        for (int s = 0; s < 8; ++s)
#pragma unroll
            for (int dt = 0; dt < 4; ++dt) { const f32x4 a = *(const f32x4*)(pv + (size_t)dt * 32 * 128 + 16 * s), bq = *(const f32x4*)(pv + (size_t)dt * 32 * 128 + 16 * s + 4);
                acc[dt] = MFMA32(qf[s], pack8(a[0], a[1], a[2], a[3], bq[0], bq[1], bq[2], bq[3]), acc[dt]); }
#pragma unroll
        for (int r = 0; r < 16; ++r) { const float sc = __builtin_amdgcn_exp2f((float)(32 * ib + crow(r, hi) + 1) * lg);
#pragma unroll
            for (int dt = 0; dt < 4; ++dt) acc[dt][r] *= sc; }
    }
    const float colsc = __builtin_amdgcn_exp2f((float)(32 * ib + r32 - 127) * lg);
    const int vlo = (4 * hi + ((lane & 15) >> 2)) * RT_VP + (16 * ((lane >> 4) & 1) + 4 * (lane & 3)) * 2;
#pragma unroll 1
    for (int jb = 0; jb <= ib; ++jb) {
        f32x16 X = (f32x16){};
        const bf16* kp = at(RK + (t0 + 32 * jb) * 512 + h * 128, (unsigned)(r32 * 512 + 8 * hi) * 2u);
#pragma unroll
        for (int s = 0; s < 8; ++s) X = MFMA32(*(const bf16x8*)(kp + 16 * s), qf[s], X);
#pragma unroll
        for (int r = 0; r < 16; ++r) { X[r] *= colsc; if (jb == ib && crow(r, hi) > r32) X[r] = 0.f; }
        const bf16x8 pa0 = pack8(X[0], X[1], X[2], X[3], X[4], X[5], X[6], X[7]), pa1 = pack8(X[8], X[9], X[10], X[11], X[12], X[13], X[14], X[15]);
        const LAS unsigned char* vb = vt + vlo + 32 * jb * RT_VP;
#pragma unroll
        for (int dt = 0; dt < 4; ++dt) {
            const bf16x8 v0 = tr_frag(vb + dt * 64, vb + 8 * RT_VP + dt * 64), v1 = tr_frag(vb + 16 * RT_VP + dt * 64, vb + 24 * RT_VP + dt * 64);
            acc[dt] = MFMA32(pa0, v0, acc[dt]); acc[dt] = MFMA32(pa1, v1, acc[dt]);
        }
    }
#pragma unroll
    for (int r = 0; r < 16; ++r) {
        float s1 = (acc[0][r] + acc[1][r]) + (acc[2][r] + acc[3][r]);
        float s2 = (acc[0][r] * acc[0][r] + acc[1][r] * acc[1][r]) + (acc[2][r] * acc[2][r] + acc[3][r] * acc[3][r]);
#pragma unroll
        for (int o = 1; o < 32; o <<= 1) { s1 += __shfl_xor(s1, o); s2 += __shfl_xor(s2, o); }
        const float mean = s1 * (1.0f / 128.0f), var = fmaxf(s2 * (1.0f / 128.0f) - mean * mean, 0.f), rstd = 1.0f / sqrtf(var + EPS);
        const int rl = crow(r, hi);
#pragma unroll
        for (int dt = 0; dt < 4; ++dt) { const float g = bf2f(*at(RG + (t0 + 32 * ib) * 512 + h * 128, (unsigned)(rl * 512 + 32 * dt + r32) * 2u));
            const unsigned w = cvt_pk((acc[dt][r] - mean) * rstd * g, 0.f); *at(Y + (t0 + 32 * ib) * D + 512 + h * 128, (unsigned)(rl * D + 32 * dt + r32) * 2u) = (bf16)(w & 0xffffu); }
    }
    __syncthreads();
}

constexpr int N_PHASES = 12;
struct Args { const void* in[21]; float* out; unsigned char* ws; int ph_lo, ph_hi, flags, li; };
__global__ void __launch_bounds__(NWAVES * 64, 2) hymba_fwd(Args args) {
    extern __shared__ __attribute__((aligned(16))) unsigned char lds_raw[];
    Frame F;
    F.lds = (LAS unsigned char*)lds_raw;
    F.tid = threadIdx.x; F.lane = F.tid & 63; F.wave = __builtin_amdgcn_readfirstlane(F.tid >> 6);
    F.G = gridDim.x; { const int bx = blockIdx.x; F.vcu = (F.G % 8 == 0) ? (bx % 8) * (F.G / 8) + bx / 8 : bx; }
    Ptrs P;
    P.x = (const float*)args.in[0]; P.mem = (const float*)args.in[1]; P.pos = (const int*)args.in[2]; P.g_mix = (const float*)args.in[3]; P.w_in = (const float*)args.in[4];
    P.g_q_lat = (const float*)args.in[5]; P.w_uq = (const float*)args.in[6]; P.g_kv_lat = (const float*)args.in[7]; P.w_ukv = (const float*)args.in[8]; P.w_out = (const float*)args.in[9];
    P.g_xattn = (const float*)args.in[10]; P.g_mem = (const float*)args.in[11]; P.w_xq = (const float*)args.in[12]; P.w_xkv = (const float*)args.in[13]; P.w_xo = (const float*)args.in[14];
    P.g_ffn = (const float*)args.in[15]; P.w_ffn_in = (const float*)args.in[16]; P.conv_w = (const float*)args.in[17]; P.conv_b = (const float*)args.in[18]; P.w_ffn_out = (const float*)args.in[19];
    P.g_final = (const float*)args.in[20]; P.out = args.out; P.ws = args.ws;
    unsigned char* ws = args.ws;
    gu32* ctl = (gu32*)(ws + WS_CTL);
    volatile LAS unsigned* MISC = (volatile LAS unsigned*)(F.lds + MISC_OFF);
    for (int u = F.tid; u < (LDS_BYTES - LDSCTL_OFF) / 4; u += NWAVES * 64) ((LAS unsigned*)(F.lds + LDSCTL_OFF))[u] = 0u;
    __syncthreads();
    XcdBarrier bar; bar.bar = (unsigned*)(ctl + CW_BAR) + args.li * XCD_BAR_WORDS; bar.x = 0; bar.st = nullptr;
    if (MK_N_LAUNCHES == 1) bar = xcd_barrier_post((unsigned*)(ctl + CW_BAR) + args.li * XCD_BAR_WORDS, MISC + 8);
    const int lo = args.ph_lo, hi_ph = args.ph_hi;
#ifndef PH_MASK
#define PH_MASK 0xFFF
#endif
#define IN(k) ((((PH_MASK) >> (k)) & 1) && lo <= (k) && (k) < hi_ph)
#define SEAM(k) do { if (IN(k) && IN((k) + 1)) xcd_barrier(bar); } while (0)

    bf16* Win = (bf16*)(ws + WS_WIN); bf16* Wup = (bf16*)(ws + WS_WUP); bf16* Wout = (bf16*)(ws + WS_WOUT); bf16* Wxq = (bf16*)(ws + WS_WXQ); bf16* Wxkv = (bf16*)(ws + WS_WXKV);
    bf16* Wxo = (bf16*)(ws + WS_WXO); bf16* Wffi = (bf16*)(ws + WS_WFFI); bf16* Wffo = (bf16*)(ws + WS_WFFO);
    float* CS = (float*)(ws + WS_CS); float* SSQL = (float*)(ws + WS_SSQL); float* SSQ1 = (float*)(ws + WS_SSQ1); float* SSQ2 = (float*)(ws + WS_SSQ2);
    bf16* MEMN = (bf16*)(ws + WS_MEMN); bf16* KH = (bf16*)(ws + WS_KH); bf16* VTH = (bf16*)(ws + WS_VTH); bf16* PX = (bf16*)(ws + WS_PX); float* SUMP = (float*)(ws + WS_SUMP);
    bf16* XN = (bf16*)(ws + WS_A); bf16* Y = (bf16*)(ws + WS_A); bf16* XB2 = (bf16*)(ws + WS_A);
    bf16* LAT = (bf16*)(ws + WS_LAT); bf16* KR = (bf16*)(ws + WS_KR); bf16* RQ = (bf16*)(ws + WS_RQ); bf16* RK = (bf16*)(ws + WS_RK); bf16* RV = (bf16*)(ws + WS_RV); bf16* RG = (bf16*)(ws + WS_RG);
    bf16* QKV = (bf16*)(ws + WS_C); float* KVT = (float*)(ws + WS_KVT);
    bf16* XB1 = (bf16*)(ws + WS_XB1); bf16* HB = (bf16*)(ws + WS_H); bf16* QX = (bf16*)(ws + WS_QX); bf16* OX = (bf16*)(ws + WS_OX);
    const int bx = (int)blockIdx.x;

    if (IN(0)) { p0_prologue(F, P); }
    SEAM(0);
    if (IN(1)) {
        pg8::Gemm g{XN, Win, D, 64, 0, 0}; pg8::StaticOrder S; S.init(M / 256, NPROJ / 256, F.G, bx);
        EpiProj E{LAT, KR, RQ, RK, RV, RG, SSQL, CS};
        pg8::gemm_phase(F.lds, g, S, E);
    }
    SEAM(1);
    if (IN(2)) {
        { pg8::Gemm g{LAT, Wup, NLAT, 64, 0, 0}; pg8::StaticOrder S; S.init(M / 256, NUP / 256, F.G, bx); EpiUp E{QKV, SSQL, CS}; pg8::gemm_phase(F.lds, g, S, E); }
        { pg8::Gemm g{MEMN, Wxkv, D, 64, 0, 0}; pg8::StaticOrder S; S.init(4, 4, F.G, (bx + 64) % F.G); EpiTile E{KH, 4, 1, nullptr, 1.0f}; pg8::gemm_phase(F.lds, g, S, E); }
        { pg8::Gemm g{Wxkv + (size_t)1024 * D, MEMN, D, 64, 0, 0}; pg8::StaticOrder S; S.init(4, 4, F.G, (bx + 48) % F.G); EpiTile E{VTH, 1, 4, nullptr, 1.0f}; pg8::gemm_phase(F.lds, g, S, E); }
        __syncthreads();
        for (int U = F.vcu; U < 512; U += F.G) ret_kv_unit(F, U, RK, RV, KVT);
    }
    SEAM(2);
    if (IN(3)) {
        if (!(args.flags & 1)) ret_scan(F, KVT);
        for (int v = F.vcu; v < 256; v += F.G) { const int bh = v >> 3, s = v & 7;
            mla_unit(F, bh >> 3, bh & 7, 15 - s, QKV, KR, Y); mla_unit(F, bh >> 3, bh & 7, s, QKV, KR, Y); }
    }
    SEAM(3);
    if (IN(4)) { for (int p = F.vcu; p < 256; p += F.G) ret_out_pair(F, p, RQ, RK, RV, RG, KVT, Y); }
    SEAM(4);
    if (IN(5)) { pg8::Gemm g{Y, Wout, D, 64, 0, 0}; pg8::StaticOrder S; S.init(M / 256, 4, F.G, bx); EpiRes E{P.x, P.out, XB1, SSQ1}; pg8::gemm_phase(F.lds, g, S, E); }
    SEAM(5);
    if (IN(6)) {
        { pg8::Gemm g{XB1, Wxq, D, 64, 0, 0}; pg8::StaticOrder S; S.init(M / 256, 4, F.G, bx); EpiTile E{QX, 1, M / 256, SSQ1, C2_X}; pg8::gemm_phase(F.lds, g, S, E); }
        { pg8::Gemm g{QX, KH, 256, 64, M / 256, 4}; pg8::StaticOrder S; S.init(M / 256, 4, F.G, bx); EpiSoftmax E{PX, SUMP}; pg8::gemm_phase(F.lds, g, S, E); }
        { pg8::Gemm g{PX, VTH, 256, 64, M / 256, 4}; pg8::StaticOrder S; S.init(M / 256, 4, F.G, bx); EpiPV E{OX, SUMP}; pg8::gemm_phase(F.lds, g, S, E); }
    }
    SEAM(6);
    if (IN(8)) { pg8::Gemm g{OX, Wxo, D, 64, 0, 0}; pg8::StaticOrder S; S.init(M / 256, 4, F.G, bx); EpiRes E{P.out, P.out, XB2, SSQ2}; pg8::gemm_phase(F.lds, g, S, E); }
    SEAM(8);
    if (IN(9)) { pg8::Gemm g{XB2 - 2 * D, Wffi, D, FF_BLK, 0, 0}; pg8::StaticOrder S; S.init(FF_NM, NFF / 256, F.G, bx); EpiFfn E{HB, SSQ2, P.conv_w, P.conv_b}; pg8::gemm_phase(F.lds, g, S, E); }
    SEAM(9);
    if (IN(10)) { pg8::Gemm g{HB, Wffo, DFF, 64, 0, 0}; pg8::StaticOrder S; S.init(M / 256, 4, F.G, bx); EpiRes E{P.out, P.out, nullptr, nullptr}; pg8::gemm_phase(F.lds, g, S, E); }
    SEAM(10);
    if (IN(11)) {
        const int gw = F.vcu * NWAVES + F.wave, NGW = F.G * NWAVES, lane = F.lane;
        for (int m = gw; m < M; m += NGW) {
            f32x4* xr = (f32x4*)(P.out + (size_t)m * D) + lane; f32x4 v[4]; float s = 0.f;
#pragma unroll
            for (int j = 0; j < 4; ++j) { v[j] = xr[64 * j]; s += (v[j][0] * v[j][0] + v[j][1] * v[j][1]) + (v[j][2] * v[j][2] + v[j][3] * v[j][3]); }
            const float inv = 1.0f / sqrtf(wave_sum(s) * (1.0f / D) + EPS);
#pragma unroll
            for (int j = 0; j < 4; ++j) xr[64 * j] = v[j] * inv * ((const f32x4*)P.g_final)[lane + 64 * j];
        }
    }
#undef IN
#undef SEAM
}

extern "C" void kernel_launch(void* const* d_in, const int* in_sizes, int n_in, void* d_out, int out_size, void* d_ws, size_t ws_size, hipStream_t stream) {
    static int grid = 0;
    if (grid == 0) {
        int dev = 0, cus = 0;
        if (n_in != 21 || out_size != M * D || ws_size < WS_END) { fprintf(stderr, "kernel_launch: unexpected problem (n_in %d, out %d, ws %zu); nothing launched\n", n_in, out_size, ws_size); grid = -1; return; }
        if (hipGetDevice(&dev) != hipSuccess || hipDeviceGetAttribute(&cus, hipDeviceAttributeMultiprocessorCount, dev) != hipSuccess) { grid = -1; return; }
        if (hipFuncSetAttribute((const void*)hymba_fwd, hipFuncAttributeMaxDynamicSharedMemorySize, LDS_BYTES) != hipSuccess) { fprintf(stderr, "kernel_launch: hipFuncSetAttribute failed\n"); grid = -1; return; }
        int per_cu = 0;
        if (hipOccupancyMaxActiveBlocksPerMultiprocessor(&per_cu, (const void*)hymba_fwd, NWAVES * 64, LDS_BYTES) != hipSuccess || per_cu < 1) fprintf(stderr, "kernel_launch: occupancy query says %d blocks per CU\n", per_cu);
        (void)hipGetLastError();
        grid = cus;
    }
    if (grid < 0) return;
    if (hipMemsetAsync((char*)d_ws + WS_CTL, 0, CTL_ZERO_BYTES, stream) != hipSuccess) return;
    Args a{};
    for (int i = 0; i < 21; ++i) a.in[i] = d_in[i];
    a.out = (float*)d_out; a.ws = (unsigned char*)d_ws;
#ifdef PROBE_PHASE
    a.ph_lo = 0; a.ph_hi = PROBE_PHASE + 1; hipLaunchKernelGGL(hymba_fwd, dim3(grid), dim3(NWAVES * 64), LDS_BYTES, stream, a);
    a.ph_lo = PROBE_PHASE; a.ph_hi = PROBE_PHASE + 1; a.flags = 1; a.li = 1; hipLaunchKernelGGL(hymba_fwd, dim3(grid), dim3(NWAVES * 64), LDS_BYTES, stream, a);
    a.ph_lo = PROBE_PHASE + 1; a.ph_hi = N_PHASES; a.flags = 0; a.li = 2; hipLaunchKernelGGL(hymba_fwd, dim3(grid), dim3(NWAVES * 64), LDS_BYTES, stream, a);
#else
    if (MK_N_LAUNCHES == 1) { a.ph_lo = 0; a.ph_hi = N_PHASES; hipLaunchKernelGGL(hymba_fwd, dim3(grid), dim3(NWAVES * 64), LDS_BYTES, stream, a); }
#endif
#ifndef PROBE_PHASE
    else for (int p = 0; p < N_PHASES; ++p) { a.ph_lo = p; a.ph_hi = p + 1; hipLaunchKernelGGL(hymba_fwd, dim3(grid), dim3(NWAVES * 64), LDS_BYTES, stream, a); }
#endif
}
```

```cpp
#include <hip/hip_runtime.h>
#include <cstdio>
#include <cstdint>
#include <cmath>

#ifndef MK_N_LAUNCHES
#define MK_N_LAUNCHES 1
#endif

typedef unsigned short bf16;
typedef short bf16x8 __attribute__((ext_vector_type(8)));
typedef short s16x4 __attribute__((ext_vector_type(4)));
typedef float f32x4 __attribute__((ext_vector_type(4)));
typedef float f32x2 __attribute__((ext_vector_type(2)));
typedef float f32x16 __attribute__((ext_vector_type(16)));
typedef unsigned u32x4 __attribute__((ext_vector_type(4)));
typedef unsigned u32x2 __attribute__((ext_vector_type(2)));
#define LAS __attribute__((address_space(3)))
#define GAS __attribute__((address_space(1)))
typedef GAS unsigned gu32;

constexpr int NB = 4, SEQ = 4096, D = 1024, M = NB * SEQ;
constexpr int NPROJ = 2560;
constexpr int NLAT = 384;
constexpr int NUP = 1792;
constexpr int DFF = 2816, NFF = 2 * DFF;
constexpr float EPS = 1e-6f;
constexpr float LOG2E = 1.4426950408889634f;
constexpr float C2_MLA = 0.10206207261596575f * LOG2E;
constexpr float C2_X = 0.0625f * LOG2E;
constexpr float RET_KSCALE = 0.08838834764831845f;
constexpr int FF_BLK = 62, FF_TROWS = 4 * FF_BLK, FF_NM = (M + FF_TROWS - 1) / FF_TROWS;

constexpr size_t MiB = 1u << 20;
constexpr size_t WS_CTL = 0, CTL_ZERO_BYTES = 1 * MiB;
constexpr size_t WS_WIN = 1 * MiB;
constexpr size_t WS_WUP = 6 * MiB;
constexpr size_t WS_WOUT = 8 * MiB, WS_WXQ = 10 * MiB, WS_WXKV = 12 * MiB, WS_WXO = 16 * MiB;
constexpr size_t WS_WFFI = 18 * MiB;
constexpr size_t WS_WFFO = 29 * MiB;
constexpr size_t WS_CS = 35 * MiB;
constexpr size_t WS_SSQL = 43 * MiB;
constexpr size_t WS_SSQ1 = 44 * MiB, WS_SSQ2 = 45 * MiB;
constexpr size_t WS_MEMN = 46 * MiB, WS_MKV = 48 * MiB;
constexpr size_t WS_A = 52 * MiB;
constexpr size_t WS_B = 84 * MiB;
constexpr size_t WS_LAT = WS_B, WS_KR = WS_B + 12 * MiB, WS_RQ = WS_B + 13 * MiB, WS_RK = WS_B + 29 * MiB, WS_RV = WS_B + 45 * MiB, WS_RG = WS_B + 61 * MiB;
constexpr size_t WS_C = 161 * MiB;
constexpr size_t WS_KVT = 217 * MiB;
constexpr size_t WS_XB1 = WS_B, WS_H = WS_B, WS_QX = 172 * MiB, WS_PX = 204 * MiB, WS_OX = 116 * MiB;
constexpr size_t WS_SUMP = 249 * MiB;
constexpr size_t WS_KH = WS_MKV, WS_VTH = WS_MKV + 2 * MiB;
constexpr size_t WS_END = 256 * MiB;
static_assert(WS_KVT + 32 * MiB <= WS_END && WS_PX + 32 * MiB <= WS_END && WS_SUMP + MiB <= WS_END && WS_H + (size_t)M * DFF * 2 <= WS_QX, "d_ws map");
constexpr int CW_TMO = 0, CW_BAR = 4096;

constexpr int RING_BYTES = 131072, LDSCTL_OFF = RING_BYTES, MISC_OFF = LDSCTL_OFF + 320, EPI_LDS_OFF = LDSCTL_OFF + 1024  , LDS_BYTES = 147456;

#define RLX_AGENT __ATOMIC_RELAXED, __HIP_MEMORY_SCOPE_AGENT
typedef __bf16 bf16x2_t __attribute__((ext_vector_type(2)));
__device__ __forceinline__ unsigned cvt_pk(float lo, float hi) { const f32x2 v = {lo, hi}; const bf16x2_t b = __builtin_convertvector(v, bf16x2_t); return __builtin_bit_cast(unsigned, b); }
__device__ __forceinline__ float bf2f(unsigned short b) { return __uint_as_float((unsigned)b << 16); }
__device__ __forceinline__ float wave_sum(float v) {
#pragma unroll
    for (int o = 1; o < 64; o <<= 1) v += __shfl_xor(v, o);
    return v;
}
__device__ __forceinline__ float silu_f(float x) { return x * __builtin_amdgcn_rcpf(1.0f + __builtin_amdgcn_exp2f(-x * LOG2E)); }
__device__ __forceinline__ int crow(int r, int hi) { return (r & 3) + 8 * (r >> 2) + 4 * hi; }
__device__ __forceinline__ bf16x8 pack8(float a0, float a1, float a2, float a3, float a4, float a5, float a6, float a7) {
    u32x4 w; w.x = cvt_pk(a0, a1); w.y = cvt_pk(a2, a3); w.z = cvt_pk(a4, a5); w.w = cvt_pk(a6, a7); return __builtin_bit_cast(bf16x8, w);
}
typedef short v4i16_t __attribute__((ext_vector_type(4)));
__device__ __forceinline__ s16x4 tr_read(const LAS unsigned char* p) { return __builtin_bit_cast(s16x4, __builtin_amdgcn_ds_read_tr16_b64_v4i16((LAS v4i16_t*)p)); }
__device__ __forceinline__ bf16x8 tr_frag(const LAS unsigned char* p0, const LAS unsigned char* p1) {
    const s16x4 lo = tr_read(p0), hi = tr_read(p1);
    return (bf16x8){lo[0], lo[1], lo[2], lo[3], hi[0], hi[1], hi[2], hi[3]};
}
template <class T> __device__ __forceinline__ T* at(T* base, unsigned byte_off) { return (T*)((char*)base + byte_off); }
template <class T> __device__ __forceinline__ const T* at(const T* base, unsigned byte_off) { return (const T*)((const char*)base + byte_off); }
#define MFMA32(a, b, c) __builtin_amdgcn_mfma_f32_32x32x16_bf16((a), (b), (c), 0, 0, 0)

namespace pg8 {
constexpr int BM = 256, BK = 64, HALF = 128, HTB = HALF * BK * 2, STAGE_BYTES = 8 * HTB, NXCD = 8, WGM = 8;
__host__ __device__ __forceinline__ int lds_byte(int r, int c) { const int st = (r >> 4) * 2 + (c >> 5), rr = r & 15, cc = c & 31, ob = rr * 64 + cc * 2; return st * 1024 + (ob ^ (((ob >> 9) & 1) << 5)); }
__host__ __device__ __forceinline__ void stage_rc(int b, int& R, int& C) { const int st = b / 1024, sb = b % 1024, swz = sb ^ (((sb >> 9) & 1) << 5); R = (st >> 1) * 16 + swz / 64; C = (st & 1) * 32 + (swz % 64) / 2; }
__host__ __device__ __forceinline__ int perm32(int rho) { const int n = rho >> 4, i = rho & 15; return 8 * (i >> 2) + 4 * n + (i & 3); }

struct Unit { int pm, pn; };
struct Gemm { const bf16* A; const bf16* Bt; int K; int a_blk; int a_pn; int b_pm; };

struct StaticOrder {
    int nM, nN, nwg, G, c;
    __device__ void init(int nM_, int nN_, int G_, int c_) { nM = nM_; nN = nN_; nwg = nM * nN; G = G_; c = c_; }
    __device__ bool next(int i, Unit& u) const {
        const long L = (long)i * G + c; if (L >= nwg) return false;
        int wgid = (int)L; { const int q = nwg / NXCD, r = nwg % NXCD, xcd = wgid % NXCD, off = wgid / NXCD; wgid = (xcd < r ? xcd * (q + 1) : r * (q + 1) + (xcd - r) * q) + off; }
        const int nig = WGM * nN, gid = wgid / nig, fm = gid * WGM, gsz = (nM - fm) < WGM ? (nM - fm) : WGM;
        u.pm = fm + ((wgid % nig) % gsz); u.pn = (wgid % nig) / gsz; return true;
    }
};

template <class Epi>
__device__ __forceinline__ void gemm_phase(LAS unsigned char* lds, const Gemm g, const StaticOrder& S, const Epi& E) {
    int tid = threadIdx.x; asm volatile("" : "+v"(tid));
    const int wid = __builtin_amdgcn_readfirstlane(tid >> 6), lane = tid & 63, wr = wid >> 2, wc = wid & 3, fr = lane & 15, fq = lane >> 4;
    const int K = g.K, nt = K / BK;
    unsigned voffA[2], voffB[2];
#pragma unroll
    for (int i = 0; i < 2; ++i) { int R, C; stage_rc(tid * 16 + i * 8192, R, C); const int Rb = (R & ~31) + perm32(R & 31); const int Ra = (R >> 6) * g.a_blk + (R & 63);
        voffA[i] = (unsigned)(Ra * K + C) * 2u; voffB[i] = (unsigned)(Rb * K + C) * 2u; }
    const size_t kstep = (size_t)(BK * 2);
    const size_t hstepA = (size_t)2 * g.a_blk * K * 2, tstepA = 2 * hstepA;
    const size_t hstepB = (size_t)HALF * K * 2, tstepB = 2 * hstepB;
    const unsigned ldsw = (unsigned)wid * 1024u;
    const int aoff = lds_byte(wr * 64 + fr, fq * 8), boff = lds_byte(wc * 32 + fr, fq * 8);
#define PG8_SA(b, h) (((b) * 2 + (h)) * HTB)
#define PG8_SB(b, h) ((4 + (b) * 2 + (h)) * HTB)
#define PG8_STAGE(bufoff, gbase, voff) do { _Pragma("unroll") for (int _i = 0; _i < 2; ++_i) \
        __builtin_amdgcn_global_load_lds((const unsigned*)((const char*)(gbase) + (voff)[_i]), (LAS unsigned*)(lds + (bufoff) + ldsw + _i * 8192), 16, 0, 0); } while (0)
#define PG8_LDA(dst, b, h) do { _Pragma("unroll") for (int m = 0; m < 4; ++m) _Pragma("unroll") for (int k = 0; k < 2; ++k) dst[m][k] = *(const LAS bf16x8*)(lds + PG8_SA(b, h) + aoff + m * 2048 + k * 1024); } while (0)
#define PG8_LDB(dst, b, h) do { _Pragma("unroll") for (int n = 0; n < 2; ++n) _Pragma("unroll") for (int k = 0; k < 2; ++k) dst[n][k] = *(const LAS bf16x8*)(lds + PG8_SB(b, h) + boff + n * 2048 + k * 1024); } while (0)
#define PG8_MMA(ai, bj, At, Bt) do { __builtin_amdgcn_s_setprio(1); _Pragma("unroll") for (int m = 0; m < 4; ++m) _Pragma("unroll") for (int n = 0; n < 2; ++n) _Pragma("unroll") for (int k = 0; k < 2; ++k) \
        acc[ai][bj][m][n] = __builtin_amdgcn_mfma_f32_16x16x32_bf16(Bt[n][k], At[m][k], acc[ai][bj][m][n], 0, 0, 0); __builtin_amdgcn_s_setprio(0); } while (0)
#define PG8_WAIT_V(n) asm volatile("s_waitcnt vmcnt(" #n ")" ::: "memory")
#define PG8_WAIT_L(n) asm volatile("s_waitcnt lgkmcnt(" #n ")" ::: "memory")
#define PG8_BAR __builtin_amdgcn_s_barrier()
#define PG8_SCHED __builtin_amdgcn_sched_barrier(0)
    Unit cur, nxt; int ui = 0;
    if (!S.next(0, cur)) return;
    f32x4 acc[2][2][4][2];
#pragma unroll
    for (int a = 0; a < 2; ++a)
#pragma unroll
        for (int b = 0; b < 2; ++b)
#pragma unroll
            for (int m = 0; m < 4; ++m)
#pragma unroll
                for (int n = 0; n < 2; ++n) acc[a][b][m][n] = (f32x4){0.f, 0.f, 0.f, 0.f};
    bf16x8 At[4][2], B0[2][2], B1[2][2];
    const char* cA = (const char*)g.A + (size_t)(cur.pm + cur.pn * g.a_pn) * tstepA; const char* cB = (const char*)g.Bt + (size_t)(cur.pn + (cur.pm >> 4) * g.b_pm) * tstepB;
    PG8_STAGE(PG8_SB(0, 0), cB, voffB); PG8_STAGE(PG8_SB(0, 1), cB + hstepB, voffB); PG8_STAGE(PG8_SA(0, 0), cA, voffA); PG8_STAGE(PG8_SA(0, 1), cA + hstepA, voffA);
    if (wr == 1) PG8_BAR;
    PG8_WAIT_V(2); PG8_BAR;
    PG8_STAGE(PG8_SB(1, 0), cB + kstep, voffB); PG8_STAGE(PG8_SA(1, 0), cA + kstep, voffA); PG8_STAGE(PG8_SB(1, 1), cB + hstepB + kstep, voffB);
    PG8_WAIT_V(6); PG8_BAR;
    for (;;) {
        const bool has_next = S.next(ui + 1, nxt);
        const char* nA = has_next ? (const char*)g.A + (size_t)(nxt.pm + nxt.pn * g.a_pn) * tstepA : cA; const char* nB = has_next ? (const char*)g.Bt + (size_t)(nxt.pn + (nxt.pm >> 4) * g.b_pm) * tstepB : cB;
#pragma unroll 1
        for (int t = 0; t < nt; t += 2) {
            const bool last = (t == nt - 2);
            const char* a1 = cA + (size_t)(t + 1) * kstep;
            const char* a2 = last ? nA : cA + (size_t)(t + 2) * kstep; const char* b2 = last ? nB : cB + (size_t)(t + 2) * kstep;
            const char* a3 = a2 + kstep; const char* b3 = b2 + kstep;
            PG8_LDB(B0, 0, 0); PG8_LDB(B1, 0, 1); PG8_SCHED; PG8_LDA(At, 0, 0); PG8_STAGE(PG8_SA(1, 1), a1 + hstepA, voffA);
            PG8_WAIT_V(8); PG8_WAIT_L(0); PG8_BAR; PG8_MMA(0, 0, At, B0); PG8_MMA(0, 1, At, B1); PG8_BAR; PG8_SCHED;
            PG8_LDA(At, 0, 1); PG8_STAGE(PG8_SB(0, 0), b2, voffB); PG8_STAGE(PG8_SB(0, 1), b2 + hstepB, voffB); PG8_STAGE(PG8_SA(0, 0), a2, voffA);
            PG8_WAIT_V(8); PG8_WAIT_L(0); PG8_BAR; PG8_MMA(1, 0, At, B0); PG8_MMA(1, 1, At, B1); PG8_BAR; PG8_SCHED;
            PG8_LDB(B0, 1, 0); PG8_LDB(B1, 1, 1); PG8_SCHED; PG8_LDA(At, 1, 0); PG8_STAGE(PG8_SA(0, 1), a2 + hstepA, voffA);
            PG8_WAIT_V(8); PG8_WAIT_L(0); PG8_BAR; PG8_MMA(0, 0, At, B0); PG8_MMA(0, 1, At, B1); PG8_BAR; PG8_SCHED;
            PG8_LDA(At, 1, 1); PG8_STAGE(PG8_SB(1, 0), b3, voffB); PG8_STAGE(PG8_SB(1, 1), b3 + hstepB, voffB); PG8_STAGE(PG8_SA(1, 0), a3, voffA);
            PG8_WAIT_V(8); PG8_WAIT_L(0); PG8_BAR; PG8_MMA(1, 0, At, B0); PG8_MMA(1, 1, At, B1); PG8_BAR; PG8_SCHED;
        }
        if (wr == 0) PG8_BAR;
        E(acc, cur, wr, wc, fr, fq, lds);
        if (!has_next) break;
#pragma unroll
        for (int a = 0; a < 2; ++a)
#pragma unroll
            for (int b = 0; b < 2; ++b)
#pragma unroll
                for (int m = 0; m < 4; ++m)
#pragma unroll
                    for (int n = 0; n < 2; ++n) acc[a][b][m][n] = (f32x4){0.f, 0.f, 0.f, 0.f};
        cur = nxt; cA = nA; cB = nB; ++ui;
        if (wr == 1) PG8_BAR;
    }
    PG8_WAIT_V(0);
    PG8_BAR;
#undef PG8_SA
#undef PG8_SB
#undef PG8_STAGE
#undef PG8_LDA
#undef PG8_LDB
#undef PG8_MMA
#undef PG8_WAIT_V
#undef PG8_WAIT_L
#undef PG8_BAR
#undef PG8_SCHED
}
}

typedef f32x4 Acc[2][2][4][2];
__device__ __forceinline__ void st8bf(bf16* p, const f32x4 a, const f32x4 b) { u32x4 w; w.x = cvt_pk(a[0], a[1]); w.y = cvt_pk(a[2], a[3]); w.z = cvt_pk(b[0], b[1]); w.w = cvt_pk(b[2], b[3]); *(u32x4*)p = w; }
__device__ __forceinline__ float ssq8(const f32x4 a, const f32x4 b) { return (a[0] * a[0] + a[1] * a[1]) + (a[2] * a[2] + a[3] * a[3]) + (b[0] * b[0] + b[1] * b[1]) + (b[2] * b[2] + b[3] * b[3]); }
__device__ __forceinline__ float red_fq(float s) { s += __shfl_xor(s, 16); s += __shfl_xor(s, 32); return s; }
__device__ __forceinline__ f32x4 rot2(const f32x4 v, const f32x4 cs) { return (f32x4){v[0] * cs[0] - v[1] * cs[1], v[1] * cs[0] + v[0] * cs[1], v[2] * cs[2] - v[3] * cs[3], v[3] * cs[2] + v[2] * cs[3]}; }

struct EpiProj {
    bf16 *LAT, *KR, *RQ, *RK, *RV, *RG; float* SSQL; const float* CS;
    __device__ __forceinline__ void operator()(const Acc& acc, const pg8::Unit& u, int wr, int wc, int fr, int fq, LAS unsigned char*) const {
        const int pn = u.pn;
#pragma unroll
        for (int ai = 0; ai < 2; ++ai)
#pragma unroll
            for (int m = 0; m < 4; ++m) {
                const int row = u.pm * 256 + ai * 128 + wr * 64 + m * 16 + fr;
                const int cw = 32 * wc + 8 * fq;
                if (pn == 0) {
                    float s = 0.f;
#pragma unroll
                    for (int bj = 0; bj < 2; ++bj) { st8bf(at(LAT, (unsigned)(row * NLAT + bj * 128 + cw) * 2u), acc[ai][bj][m][0], acc[ai][bj][m][1]); s += ssq8(acc[ai][bj][m][0], acc[ai][bj][m][1]); }
                    s = red_fq(s); if (fq == 0) *at(SSQL, (unsigned)(row * 8 + wc) * 4u) = s;
                } else if (pn == 1) {
                    st8bf(at(LAT, (unsigned)(row * NLAT + 256 + cw) * 2u), acc[ai][0][m][0], acc[ai][0][m][1]);
                    float s = red_fq(ssq8(acc[ai][0][m][0], acc[ai][0][m][1])); if (fq == 0) *at(SSQL, (unsigned)(row * 8 + 4 + wc) * 4u) = s;
                    if (wc == 0) {
                        const float* cs = at(CS, (unsigned)row * 512u);
                        f32x4 o[2];
#pragma unroll
                        for (int n = 0; n < 2; ++n) { const int i0 = 4 * fq + 2 * n; const f32x2 a = *(const f32x2*)(cs + 8 * i0), b = *(const f32x2*)(cs + 8 * i0 + 8);
                            o[n] = rot2(acc[ai][1][m][n], (f32x4){a[0], a[1], b[0], b[1]}); }
                        st8bf(at(KR, (unsigned)(row * 32 + 8 * fq) * 2u), o[0], o[1]);
                    }
                } else if (pn < 6) {
                    const float* cs = at(CS, (unsigned)row * 512u);
#pragma unroll
                    for (int bj = 0; bj < 2; ++bj) { const int head = 2 * (pn & 1) + bj; f32x4 o[2];
#pragma unroll
                        for (int n = 0; n < 2; ++n) { const int i0 = (cw + 4 * n) >> 1; o[n] = rot2(acc[ai][bj][m][n], *(const f32x4*)(cs + 2 * i0)); }
                        if (pn < 4) st8bf(at(RQ, (unsigned)(row * 512 + head * 128 + cw) * 2u), o[0], o[1]);
                        else { const float lg = __builtin_amdgcn_logf(1.0f - __builtin_amdgcn_exp2f(-5.0f - (float)head));
                            const float w = RET_KSCALE * __builtin_amdgcn_exp2f((float)(127 - (row & 127)) * lg);
                            st8bf(at(RK, (unsigned)(row * 512 + head * 128 + cw) * 2u), o[0] * w, o[1] * w); } }
                } else if (pn < 8) {
#pragma unroll
                    for (int bj = 0; bj < 2; ++bj) st8bf(at(RV, (unsigned)(row * 512 + (pn & 1) * 256 + bj * 128 + cw) * 2u), acc[ai][bj][m][0], acc[ai][bj][m][1]);
                } else {
#pragma unroll
                    for (int bj = 0; bj < 2; ++bj) { f32x4 a = acc[ai][bj][m][0], b = acc[ai][bj][m][1];
#pragma unroll
                        for (int e = 0; e < 4; ++e) { a[e] = silu_f(a[e]); b[e] = silu_f(b[e]); }
                        st8bf(at(RG, (unsigned)(row * 512 + (pn & 1) * 256 + bj * 128 + cw) * 2u), a, b); }
                }
            }
    }
};

struct EpiUp {
    bf16* QKV; const float* SSQL; const float* CS;
    __device__ __forceinline__ void operator()(const Acc& acc, const pg8::Unit& u, int wr, int wc, int fr, int fq, LAS unsigned char*) const {
        const bool isq = u.pn < 3;
#pragma unroll
        for (int ai = 0; ai < 2; ++ai)
#pragma unroll
            for (int m = 0; m < 4; ++m) {
                const int row = u.pm * 256 + ai * 128 + wr * 64 + m * 16 + fr;
                const f32x4 sq = *(const f32x4*)at(SSQL, (unsigned)(row * 8 + (isq ? 0 : 4)) * 4u);
                const float inv = 1.0f / sqrtf(((sq[0] + sq[1]) + (sq[2] + sq[3])) * (isq ? 1.0f / 256.0f : 1.0f / 128.0f) + EPS);
                const float sc = isq ? inv * C2_MLA : inv;
                const float* cs = at(CS, (unsigned)row * 512u);
#pragma unroll
                for (int bj = 0; bj < 2; ++bj) { const int col = u.pn * 256 + bj * 128 + 32 * wc + 8 * fq; f32x4 o[2];
#pragma unroll
                    for (int n = 0; n < 2; ++n) { o[n] = acc[ai][bj][m][n] * sc; const int hc = (col + 4 * n) % 96;
                        if (isq && hc >= 64) { const int i0 = (hc - 64) >> 1; const f32x2 a = *(const f32x2*)(cs + 8 * i0), b = *(const f32x2*)(cs + 8 * i0 + 8); o[n] = rot2(o[n], (f32x4){a[0], a[1], b[0], b[1]}); } }
                    st8bf(at(QKV, (unsigned)(row * NUP + col) * 2u), o[0], o[1]); }
                asm volatile("" ::: "memory");
            }
    }
};

struct EpiStore {
    bf16* O; int ldc; const float* SSQ16; float scale;
    __device__ __forceinline__ void operator()(const Acc& acc, const pg8::Unit& u, int wr, int wc, int fr, int fq, LAS unsigned char*) const {
#pragma unroll
        for (int ai = 0; ai < 2; ++ai)
#pragma unroll
            for (int m = 0; m < 4; ++m) {
                const int row = u.pm * 256 + ai * 128 + wr * 64 + m * 16 + fr;
                float sc = scale;
                if (SSQ16) { const f32x4* p = (const f32x4*)at(SSQ16, (unsigned)row * 64u); const f32x4 a = p[0], b = p[1], c = p[2], d = p[3];
                    const float t = ((a[0] + a[1]) + (a[2] + a[3])) + ((b[0] + b[1]) + (b[2] + b[3])) + ((c[0] + c[1]) + (c[2] + c[3])) + ((d[0] + d[1]) + (d[2] + d[3]));
                    sc *= 1.0f / sqrtf(t * (1.0f / 1024.0f) + EPS); }
#pragma unroll
                for (int bj = 0; bj < 2; ++bj) st8bf(at(O, (unsigned)(row * ldc + u.pn * 256 + bj * 128 + 32 * wc + 8 * fq) * 2u), acc[ai][bj][m][0] * sc, acc[ai][bj][m][1] * sc);
            }
    }
};

struct EpiTile {
    bf16* O; int tm, tn; const float* SSQ16; float scale;
    __device__ __forceinline__ void operator()(const Acc& acc, const pg8::Unit& u, int wr, int wc, int fr, int fq, LAS unsigned char*) const {
        bf16* T = O + (size_t)(u.pm * tm + u.pn * tn) * 65536;
#pragma unroll
        for (int ai = 0; ai < 2; ++ai)
#pragma unroll
            for (int m = 0; m < 4; ++m) {
                const int rl = ai * 128 + wr * 64 + m * 16 + fr;
                float sc = scale;
                if (SSQ16) { const f32x4* p = (const f32x4*)at(SSQ16, (unsigned)(u.pm * 256 + rl) * 64u); const f32x4 a = p[0], b = p[1], c = p[2], d = p[3];
                    const float t = ((a[0] + a[1]) + (a[2] + a[3])) + ((b[0] + b[1]) + (b[2] + b[3])) + ((c[0] + c[1]) + (c[2] + c[3])) + ((d[0] + d[1]) + (d[2] + d[3]));
                    sc *= 1.0f / sqrtf(t * (1.0f / 1024.0f) + EPS); }
#pragma unroll
                for (int bj = 0; bj < 2; ++bj) st8bf(at(T, (unsigned)(rl * 256 + bj * 128 + 32 * wc + 8 * fq) * 2u), acc[ai][bj][m][0] * sc, acc[ai][bj][m][1] * sc);
            }
    }
};
struct EpiSoftmax {
    bf16* PX; float* SUMP;
    __device__ __forceinline__ void operator()(const Acc& acc, const pg8::Unit& u, int wr, int wc, int fr, int fq, LAS unsigned char* lds) const {
        LAS float* PM = (LAS float*)(lds + EPI_LDS_OFF);
#pragma unroll
        for (int ai = 0; ai < 2; ++ai)
#pragma unroll
            for (int m = 0; m < 4; ++m) {
                float mx = -INFINITY;
#pragma unroll
                for (int bj = 0; bj < 2; ++bj)
#pragma unroll
                    for (int n = 0; n < 2; ++n) { const f32x4 v = acc[ai][bj][m][n]; mx = fmaxf(fmaxf(mx, fmaxf(v[0], v[1])), fmaxf(v[2], v[3])); }
                mx = fmaxf(mx, __shfl_xor(mx, 16)); mx = fmaxf(mx, __shfl_xor(mx, 32));
                if (fq == 0) PM[(ai * 128 + wr * 64 + m * 16 + fr) * 4 + wc] = mx;
            }
        asm volatile("s_waitcnt lgkmcnt(0)\n\ts_barrier" ::: "memory");
        bf16* T = PX + (size_t)(u.pn * (M / 256) + u.pm) * 65536;
#pragma unroll
        for (int ai = 0; ai < 2; ++ai)
#pragma unroll
            for (int m = 0; m < 4; ++m) {
                const int rl = ai * 128 + wr * 64 + m * 16 + fr;
                const f32x4 pm4 = *(const LAS f32x4*)(PM + rl * 4);
                const float mx = fmaxf(fmaxf(pm4[0], pm4[1]), fmaxf(pm4[2], pm4[3]));
                float s = 0.f;
#pragma unroll
                for (int bj = 0; bj < 2; ++bj) { f32x4 a = acc[ai][bj][m][0], b = acc[ai][bj][m][1];
#pragma unroll
                    for (int e = 0; e < 4; ++e) { a[e] = __builtin_amdgcn_exp2f(a[e] - mx); b[e] = __builtin_amdgcn_exp2f(b[e] - mx); }
                    s += ((a[0] + a[1]) + (a[2] + a[3])) + ((b[0] + b[1]) + (b[2] + b[3]));
                    st8bf(at(T, (unsigned)(rl * 256 + bj * 128 + 32 * wc + 8 * fq) * 2u), a, b); }
                s = red_fq(s); if (fq == 0) *at(SUMP, (unsigned)((u.pm * 256 + rl) * 16 + u.pn * 4 + wc) * 4u) = s;
            }
        asm volatile("s_waitcnt lgkmcnt(0)\n\ts_barrier" ::: "memory");
    }
};
struct EpiPV {
    bf16* OX; const float* SUMP;
    __device__ __forceinline__ void operator()(const Acc& acc, const pg8::Unit& u, int wr, int wc, int fr, int fq, LAS unsigned char*) const {
#pragma unroll
        for (int ai = 0; ai < 2; ++ai)
#pragma unroll
            for (int m = 0; m < 4; ++m) {
                const int row = u.pm * 256 + ai * 128 + wr * 64 + m * 16 + fr;
                const f32x4 sp = *(const f32x4*)at(SUMP, (unsigned)(row * 16 + u.pn * 4) * 4u);
                const float sc = 1.0f / ((sp[0] + sp[1]) + (sp[2] + sp[3]));
#pragma unroll
                for (int bj = 0; bj < 2; ++bj) st8bf(at(OX, (unsigned)(row * D + u.pn * 256 + bj * 128 + 32 * wc + 8 * fq) * 2u), acc[ai][bj][m][0] * sc, acc[ai][bj][m][1] * sc);
            }
    }
};

template <bool BF>
struct EpiRes {
    const void* base; float* out; bf16* XB; float* SSQ16;
    __device__ __forceinline__ void operator()(const Acc& acc, const pg8::Unit& u, int wr, int wc, int fr, int fq, LAS unsigned char*) const {
#pragma unroll
        for (int ai = 0; ai < 2; ++ai)
#pragma unroll
            for (int m = 0; m < 4; ++m) {
                const int row = u.pm * 256 + ai * 128 + wr * 64 + m * 16 + fr; float s = 0.f;
#pragma unroll
                for (int bj = 0; bj < 2; ++bj) { const unsigned off = (unsigned)(row * D + u.pn * 256 + bj * 128 + 32 * wc + 8 * fq);
                    f32x4 a, b;
                    if (BF) { const u32x4 w = *(const u32x4*)at((const bf16*)base, off * 2u);
                        a = (f32x4){__uint_as_float(w.x << 16), __uint_as_float(w.x & 0xffff0000u), __uint_as_float(w.y << 16), __uint_as_float(w.y & 0xffff0000u)};
                        b = (f32x4){__uint_as_float(w.z << 16), __uint_as_float(w.z & 0xffff0000u), __uint_as_float(w.w << 16), __uint_as_float(w.w & 0xffff0000u)}; }
                    else { a = *(const f32x4*)at((const float*)base, off * 4u); b = *(const f32x4*)at((const float*)base, off * 4u + 16u); }
                    a = a + acc[ai][bj][m][0]; b = b + acc[ai][bj][m][1];
                    if (out) { *(f32x4*)at(out, off * 4u) = a; *(f32x4*)at(out, off * 4u + 16u) = b; }
                    if (XB) st8bf(at(XB, off * 2u), a, b);
                    s += ssq8(a, b); }
                if (SSQ16) { s = red_fq(s); if (fq == 0) *at(SSQ16, (unsigned)(row * 16 + u.pn * 4 + wc) * 4u) = s; }
                if (m & 1) asm volatile("" ::: "memory");
            }
    }
};

struct EpiFfn {
    bf16* H; const float* SSQ16; const float* cw; const float* cb;
    __device__ __forceinline__ void operator()(const Acc& acc, const pg8::Unit& u, int wr, int wc, int fr, int fq, LAS unsigned char*) const {
        const int lane = threadIdx.x & 63;
        const int colh = u.pn * 128 + 32 * wc + 8 * fq;
        f32x4 w0[2], w1[2], w2[2], bb[2];
#pragma unroll
        for (int n = 0; n < 2; ++n) { w0[n] = *(const f32x4*)(cw + colh + 4 * n); w1[n] = *(const f32x4*)(cw + DFF + colh + 4 * n); w2[n] = *(const f32x4*)(cw + 2 * DFF + colh + 4 * n); bb[n] = *(const f32x4*)(cb + colh + 4 * n); }
        const int src1 = (lane & 48) | ((fr + 15) & 15), src2 = (lane & 48) | ((fr + 14) & 15);
#pragma unroll
        for (int ai = 0; ai < 2; ++ai) {
            const int row0 = u.pm * FF_TROWS + (2 * ai + wr) * FF_BLK - 2;
            f32x4 gp[2] = {(f32x4){0.f, 0.f, 0.f, 0.f}, (f32x4){0.f, 0.f, 0.f, 0.f}};
#pragma unroll
            for (int m = 0; m < 4; ++m) {
                const int t = row0 + m * 16 + fr;
                const int tc = t < 0 ? 0 : (t >= M ? M - 1 : t);
                const f32x4* p = (const f32x4*)at(SSQ16, (unsigned)tc * 64u); const f32x4 a = p[0], b = p[1], c = p[2], d = p[3];
                const float tt = ((a[0] + a[1]) + (a[2] + a[3])) + ((b[0] + b[1]) + (b[2] + b[3])) + ((c[0] + c[1]) + (c[2] + c[3])) + ((d[0] + d[1]) + (d[2] + d[3]));
                const float inv = 1.0f / sqrtf(tt * (1.0f / 1024.0f) + EPS);
                const int ts = t & (SEQ - 1);
                f32x4 o[2], gc[2];
#pragma unroll
                for (int n = 0; n < 2; ++n) {
                    gc[n] = acc[ai][0][m][n] * inv;
#pragma unroll
                    for (int e = 0; e < 4; ++e) {
                        const float cur = gc[n][e], prv = gp[n][e];
                        float g1 = __shfl(fr == 15 ? prv : cur, src1), g0 = __shfl(fr >= 14 ? prv : cur, src2);
                        if (ts < 1) g1 = 0.f; if (ts < 2) g0 = 0.f;
                        const float cv = bb[n][e] + w0[n][e] * g0 + w1[n][e] * g1 + w2[n][e] * cur;
                        o[n][e] = silu_f(cv) * (acc[ai][1][m][n][e] * inv);
                    }
                    gp[n] = gc[n];
                }
                if ((m > 0 || fr >= 2) && t < M) st8bf(at(H, (unsigned)(t * DFF + colh) * 2u), o[0], o[1]);
                asm volatile("" ::: "memory");
            }
        }
    }
};

#define XB_TMO      128
#define XB_XCNT(j)  (256  + 64 * (j))
#define XB_XSUB(j)  (1280 + 64 * (j))
#define XB_XGEN(j)  (2304 + 64 * (j))
#define XB_TOP      3328
#define XB_TOPGEN   3392
#define XCD_BAR_WORDS 3456
#define XB_SPIN_CAP (1u << 18)
__device__ __forceinline__ unsigned xb_ld(unsigned* p)              { return __hip_atomic_load(p, __ATOMIC_RELAXED, __HIP_MEMORY_SCOPE_AGENT); }
__device__ __forceinline__ unsigned xb_add(unsigned* p, unsigned v) { return __hip_atomic_fetch_add(p, v, __ATOMIC_RELAXED, __HIP_MEMORY_SCOPE_AGENT); }
__device__ __forceinline__ unsigned xb_xcc_id() { return (unsigned)__builtin_amdgcn_s_getreg((3 << 11) | 20) & 0xFu; }
#define XB_SPIN(cond, bar) do { unsigned _sp = 0; while (cond) { __builtin_amdgcn_s_sleep(1); \
    if ((++_sp & 255u) == 0u) { if (xb_ld(&(bar)[XB_TMO])) break; if (_sp > XB_SPIN_CAP) { atomicAdd(&(bar)[XB_TMO], 1u); break; } } } } while (0)
struct XcdBarrier { unsigned* bar; unsigned x; volatile LAS unsigned* st; };
__device__ __forceinline__ XcdBarrier xcd_barrier_post(unsigned* bar, volatile LAS unsigned* st) {
    XcdBarrier b; b.bar = bar; b.x = xb_xcc_id(); b.st = st;
    if (threadIdx.x == 0) (void)xb_add(&bar[XB_XCNT(b.x)], 1u);
    return b;
}
__device__ __forceinline__ void xcd_barrier_complete(unsigned* bar, unsigned x, unsigned& nloc, unsigned& nx) {
    const unsigned G = gridDim.x * gridDim.y * gridDim.z;
    unsigned sum, cnt, mine, sp = 0u;
    for (;;) {
        sum = 0u; cnt = 0u; mine = 0u;
#pragma unroll
        for (unsigned j = 0; j < 16; ++j) { const unsigned c = xb_ld(&bar[XB_XCNT(j)]); sum += c; cnt += (c > 0u) ? 1u : 0u; mine = (j == x) ? c : mine; }
        if (sum == G) break;
        __builtin_amdgcn_s_sleep(1);
        if ((++sp & 255u) == 0u) { if (xb_ld(&bar[XB_TMO])) break; if (sp > XB_SPIN_CAP) { atomicAdd(&bar[XB_TMO], 1u); break; } }
    }
    nloc = mine > 0u ? mine : 1u; nx = cnt > 0u ? cnt : 1u;
}
__device__ __forceinline__ void xcd_barrier(const XcdBarrier& b) {
    asm volatile("s_waitcnt vmcnt(0)" ::: "memory");
    __syncthreads();
    if (threadIdx.x == 0) {
        unsigned* bar = b.bar;
        __builtin_amdgcn_s_waitcnt(0);
        unsigned nloc = b.st[0], nx = b.st[1];
        if (nloc == 0u) { xcd_barrier_complete(bar, b.x, nloc, nx); b.st[0] = nloc; b.st[1] = nx; }
        const unsigned old = xb_add(&bar[XB_XSUB(b.x)], 1u);
        const unsigned gen = old / nloc;
        if (old + 1u == (gen + 1u) * nloc) {
            __builtin_amdgcn_fence(__ATOMIC_RELEASE, "agent");
            asm volatile("s_waitcnt vmcnt(0)" ::: "memory");
            const unsigned og = xb_add(&bar[XB_TOP], 1u);
            const unsigned tg = og / nx;
            if (og + 1u == (tg + 1u) * nx) xb_add(&bar[XB_TOPGEN], 1u);
            else XB_SPIN(xb_ld(&bar[XB_TOPGEN]) == tg, bar);
            __builtin_amdgcn_fence(__ATOMIC_ACQUIRE, "agent");
            xb_add(&bar[XB_XGEN(b.x)], 1u);
            asm volatile("s_waitcnt vmcnt(0)" ::: "memory");
        } else {
            XB_SPIN(xb_ld(&bar[XB_XGEN(b.x)]) == gen, bar);
            __builtin_amdgcn_fence(__ATOMIC_ACQUIRE, "agent");
            asm volatile("s_waitcnt vmcnt(0)" ::: "memory");
        }
    }
    __syncthreads();
}

constexpr int NWAVES = 8;
struct Frame {
    LAS unsigned char* lds; int tid, lane, wave, vcu, G;
};

__device__ __forceinline__ int map_proj(int n) {
    if (n < 384) return n;
    if (n < 416) { const int j = n - 384; return 384 + (j >> 1) + 16 * (j & 1); }
    if (n < 512) return -1;
    if (n < 1536) { const int j = n - 512, hd = j >> 7, c = j & 127; return 416 + hd * 128 + (c >> 1) + 64 * (c & 1); }
    return n - 1536 + 1440;
}
__device__ __forceinline__ int map_uq(int n) { const int h = n / 96, c = n % 96; if (c < 64) return n; const int j = c - 64; return h * 96 + 64 + (j >> 1) + 16 * (j & 1); }
__device__ __forceinline__ int map_ffi(int n) { const int t = n >> 8, c = n & 255; return (c < 128) ? t * 128 + c : DFF + t * 128 + (c - 128); }

template <int MAP>
__device__ __forceinline__ void transpose_item(const float* W, int K, int Nsrc, int Ndst, const float* g, bf16* WT, int ldk, int koff, int row_off, LAS float* scr, int item, int lane) {
    const int nblk = Ndst / 32, kb = item / nblk, nb = item % nblk, k0 = 64 * kb, n0 = 32 * nb;
    const int nd = n0 + (lane & 31);
    const int ns = MAP == 0 ? nd : (MAP == 1 ? map_proj(nd) : (MAP == 2 ? map_uq(nd) : map_ffi(nd)));
    const float* wp = at(W + (size_t)k0 * Nsrc, (unsigned)(((lane >> 5) * Nsrc + (ns < 0 ? 0 : ns)) * 4));
    float v[32];
#pragma unroll
    for (int i = 0; i < 32; ++i) v[i] = wp[(size_t)(2 * i) * Nsrc];
    const int c = lane & 7;
    f32x4 g0 = (f32x4){1.f, 1.f, 1.f, 1.f}, g1 = g0;
    if (g) { g0 = *(const f32x4*)(g + k0 + 8 * c); g1 = *(const f32x4*)(g + k0 + 8 * c + 4); }
#pragma unroll
    for (int i = 0; i < 32; ++i) scr[(2 * i + (lane >> 5)) * 33 + (lane & 31)] = ns < 0 ? 0.f : v[i];
    asm volatile("s_waitcnt lgkmcnt(0)" ::: "memory");
#pragma unroll
    for (int j = 0; j < 4; ++j) { const int n = (lane >> 3) + 8 * j; const LAS float* s = scr + (8 * c) * 33 + n;
        u32x4 o; o.x = cvt_pk(s[0 * 33] * g0[0], s[1 * 33] * g0[1]); o.y = cvt_pk(s[2 * 33] * g0[2], s[3 * 33] * g0[3]); o.z = cvt_pk(s[4 * 33] * g1[0], s[5 * 33] * g1[1]); o.w = cvt_pk(s[6 * 33] * g1[2], s[7 * 33] * g1[3]);
        *(u32x4*)(WT + (size_t)(row_off + n0 + n) * ldk + koff + k0 + 8 * c) = o; }
    asm volatile("s_waitcnt lgkmcnt(0)" ::: "memory");
}
__device__ __forceinline__ void rms_rows2_to_bf16(const float* xa, const float* xb, const float* g, bf16* oa, bf16* ob, int lane) {
    const f32x4* pa = (const f32x4*)xa + lane; const f32x4* pb = (const f32x4*)xb + lane;
    f32x4 va[4], vb[4]; float sa = 0.f, sb = 0.f;
#pragma unroll
    for (int j = 0; j < 4; ++j) { va[j] = pa[64 * j]; vb[j] = pb[64 * j]; }
#pragma unroll
    for (int j = 0; j < 4; ++j) { sa += (va[j][0] * va[j][0] + va[j][1] * va[j][1]) + (va[j][2] * va[j][2] + va[j][3] * va[j][3]); sb += (vb[j][0] * vb[j][0] + vb[j][1] * vb[j][1]) + (vb[j][2] * vb[j][2] + vb[j][3] * vb[j][3]); }
    const float ia = 1.0f / sqrtf(wave_sum(sa) * (1.0f / D) + EPS), ib = 1.0f / sqrtf(wave_sum(sb) * (1.0f / D) + EPS);
    u32x2* qa = (u32x2*)oa + lane; u32x2* qb = (u32x2*)ob + lane;
#pragma unroll
    for (int j = 0; j < 4; ++j) { f32x4 wa = va[j] * ia, wb = vb[j] * ib; if (g) { const f32x4 gg = ((const f32x4*)g)[lane + 64 * j]; wa = wa * gg; wb = wb * gg; }
        u32x2 t; t.x = cvt_pk(wa[0], wa[1]); t.y = cvt_pk(wa[2], wa[3]); qa[64 * j] = t; t.x = cvt_pk(wb[0], wb[1]); t.y = cvt_pk(wb[2], wb[3]); qb[64 * j] = t; }
}

struct Ptrs {
    const float *x, *mem; const int* pos; const float *g_mix, *w_in, *g_q_lat, *w_uq, *g_kv_lat, *w_ukv, *w_out, *g_xattn, *g_mem, *w_xq, *w_xkv, *w_xo, *g_ffn, *w_ffn_in, *conv_w, *conv_b, *w_ffn_out, *g_final;
    float* out; unsigned char* ws;
};

__device__ __forceinline__ void p0_prologue(const Frame& F, const Ptrs& P) {
    LAS float* scr = (LAS float*)(F.lds + F.wave * 16384);
    const int gw = F.vcu * NWAVES + F.wave, NGW = F.G * NWAVES, lane = F.lane;
    unsigned char* ws = P.ws;
    bf16* Win = (bf16*)(ws + WS_WIN); bf16* Wup = (bf16*)(ws + WS_WUP);
    for (int i = gw * 64 + lane; i < 768 * 16 + 1024 * 32; i += NGW * 64) {
        if (i < 768 * 16) { const int r = i >> 4, c = i & 15; *(u32x4*)(Wup + (size_t)r * NLAT + 256 + 8 * c) = (u32x4){0u, 0u, 0u, 0u}; }
        else { const int j = i - 768 * 16, r = 768 + (j >> 5), c = j & 31; *(u32x4*)(Wup + (size_t)r * NLAT + 8 * c) = (u32x4){0u, 0u, 0u, 0u}; }
    }
    constexpr int I_IN = (D / 64) * (NPROJ / 32), I_UQ = (256 / 64) * (768 / 32), I_UKV = (128 / 64) * (1024 / 32), I_SQ = (D / 64) * (D / 32), I_XKV = (D / 64) * (2048 / 32), I_FFI = (D / 64) * (NFF / 32), I_FFO = (DFF / 64) * (D / 32);
    constexpr int NITEMS = I_IN + I_UQ + I_UKV + 3 * I_SQ + I_XKV + I_FFI + I_FFO;
    for (int it = gw; it < NITEMS; it += NGW) {
        int r = it;
        if (r < I_IN) { transpose_item<1>(P.w_in, D, 2464, NPROJ, P.g_mix, Win, D, 0, 0, scr, r, lane); continue; } r -= I_IN;
        if (r < I_UQ) { transpose_item<2>(P.w_uq, 256, 768, 768, P.g_q_lat, Wup, NLAT, 0, 0, scr, r, lane); continue; } r -= I_UQ;
        if (r < I_UKV) { transpose_item<0>(P.w_ukv, 128, 1024, 1024, P.g_kv_lat, Wup, NLAT, 256, 768, scr, r, lane); continue; } r -= I_UKV;
        if (r < I_SQ) { transpose_item<0>(P.w_out, D, D, D, nullptr, (bf16*)(ws + WS_WOUT), D, 0, 0, scr, r, lane); continue; } r -= I_SQ;
        if (r < I_SQ) { transpose_item<0>(P.w_xq, D, D, D, P.g_xattn, (bf16*)(ws + WS_WXQ), D, 0, 0, scr, r, lane); continue; } r -= I_SQ;
        if (r < I_SQ) { transpose_item<0>(P.w_xo, D, D, D, nullptr, (bf16*)(ws + WS_WXO), D, 0, 0, scr, r, lane); continue; } r -= I_SQ;
        if (r < I_XKV) { transpose_item<0>(P.w_xkv, D, 2048, 2048, nullptr, (bf16*)(ws + WS_WXKV), D, 0, 0, scr, r, lane); continue; } r -= I_XKV;
        if (r < I_FFI) { transpose_item<3>(P.w_ffn_in, D, NFF, NFF, P.g_ffn, (bf16*)(ws + WS_WFFI), D, 0, 0, scr, r, lane); continue; } r -= I_FFI;
        transpose_item<0>(P.w_ffn_out, DFF, D, D, nullptr, (bf16*)(ws + WS_WFFO), DFF, 0, 0, scr, r, lane);
    }
    bf16* XN = (bf16*)(ws + WS_A); bf16* MEMN = (bf16*)(ws + WS_MEMN); float* CS = (float*)(ws + WS_CS);
    for (int m = 2 * gw; m < M + NB * 256; m += 2 * NGW) {
        if (m < M) rms_rows2_to_bf16(P.x + (size_t)m * D, P.x + (size_t)(m + 1) * D, nullptr, XN + (size_t)m * D, XN + (size_t)(m + 1) * D, lane);
        else rms_rows2_to_bf16(P.mem + (size_t)(m - M) * D, P.mem + (size_t)(m + 1 - M) * D, P.g_mem, MEMN + (size_t)(m - M) * D, MEMN + (size_t)(m + 1 - M) * D, lane);
    }
    {   const float rev_freq = exp2f(-(float)lane * (13.287712379549449f / 64.0f)) * 0.15915494309189535f;
        for (int m = gw; m < M; m += NGW) {
            const float fr = __builtin_amdgcn_fractf((float)P.pos[m] * rev_freq);
            *(f32x2*)(CS + (size_t)m * 128 + 2 * lane) = (f32x2){__builtin_amdgcn_cosf(fr), __builtin_amdgcn_sinf(fr)};
        } }
}

template <int NDT, int VP>
__device__ __forceinline__ void flash_step(f32x16& X0, f32x16& X1, f32x16 (&O)[NDT], float& mrun, float& lrun, const LAS unsigned char* vbase, LAS float* wsf, int lane) {
    const int hi = lane >> 5;
    float rm = X0[0];
#pragma unroll
    for (int r = 1; r < 16; ++r) rm = fmaxf(rm, X0[r]);
#pragma unroll
    for (int r = 0; r < 16; ++r) rm = fmaxf(rm, X1[r]);
    rm = fmaxf(rm, __shfl_xor(rm, 32));
    const float mnew = fmaxf(mrun, rm);
    const float alpha = __builtin_amdgcn_exp2f(mrun - mnew);
    mrun = mnew;
    float ps = 0.f;
#pragma unroll
    for (int r = 0; r < 16; ++r) { X0[r] = __builtin_amdgcn_exp2f(X0[r] - mnew); X1[r] = __builtin_amdgcn_exp2f(X1[r] - mnew); ps += X0[r] + X1[r]; }
    lrun = lrun * alpha + ps;
    if (__any(alpha != 1.0f)) {
        if (hi == 0) wsf[lane] = alpha;
        asm volatile("s_waitcnt lgkmcnt(0)" ::: "memory");
#pragma unroll
        for (int r = 0; r < 16; ++r) { const float a = wsf[crow(r, hi)];
#pragma unroll
            for (int dt = 0; dt < NDT; ++dt) O[dt][r] *= a; }
        asm volatile("s_waitcnt lgkmcnt(0)" ::: "memory");
    }
    const bf16x8 pa0 = pack8(X0[0], X0[1], X0[2], X0[3], X0[4], X0[5], X0[6], X0[7]), pa1 = pack8(X0[8], X0[9], X0[10], X0[11], X0[12], X0[13], X0[14], X0[15]);
    const bf16x8 pa2 = pack8(X1[0], X1[1], X1[2], X1[3], X1[4], X1[5], X1[6], X1[7]), pa3 = pack8(X1[8], X1[9], X1[10], X1[11], X1[12], X1[13], X1[14], X1[15]);
    const LAS unsigned char* vl = vbase + (4 * hi + ((lane & 15) >> 2)) * VP + (16 * ((lane >> 4) & 1) + 4 * (lane & 3)) * 2;
#pragma unroll
    for (int dt = 0; dt < NDT; ++dt) {
        const bf16x8 v0 = tr_frag(vl + 0 * 16 * VP + dt * 64, vl + (0 * 16 + 8) * VP + dt * 64);
        const bf16x8 v1 = tr_frag(vl + 1 * 16 * VP + dt * 64, vl + (1 * 16 + 8) * VP + dt * 64);
        const bf16x8 v2 = tr_frag(vl + 2 * 16 * VP + dt * 64, vl + (2 * 16 + 8) * VP + dt * 64);
        const bf16x8 v3 = tr_frag(vl + 3 * 16 * VP + dt * 64, vl + (3 * 16 + 8) * VP + dt * 64);
        O[dt] = MFMA32(pa0, v0, O[dt]); O[dt] = MFMA32(pa1, v1, O[dt]); O[dt] = MFMA32(pa2, v2, O[dt]); O[dt] = MFMA32(pa3, v3, O[dt]);
    }
}
template <int NDT>
__device__ __forceinline__ void flash_store(f32x16 (&O)[NDT], float lrun, LAS float* wsf, int lane, bf16* out, size_t ldo) {
    const int hi = lane >> 5;
    lrun += __shfl_xor(lrun, 32);
    if (hi == 0) wsf[lane] = 1.0f / lrun;
    asm volatile("s_waitcnt lgkmcnt(0)" ::: "memory");
#pragma unroll
    for (int r = 0; r < 16; ++r) { const float a = wsf[crow(r, hi)];
#pragma unroll
        for (int dt = 0; dt < NDT; ++dt) { const unsigned w = cvt_pk(O[dt][r] * a, 0.f); *at(out, (unsigned)(crow(r, hi) * (int)ldo + 32 * dt + (lane & 31)) * 2u) = (bf16)(w & 0xffffu); } }
    asm volatile("s_waitcnt lgkmcnt(0)" ::: "memory");
}

constexpr int MLA_KSLOT = 12288, MLA_VSLOT = 8192, MLA_K0 = 0, MLA_V0 = 3 * MLA_KSLOT, MLA_WS = MLA_V0 + 3 * MLA_VSLOT, MLA_OST = MLA_WS + 8 * 128, MLA_LDS = MLA_OST + 8 * 4096;
static_assert(MLA_LDS <= RING_BYTES, "MLA LDS");
__device__ __forceinline__ void glds16(const void* gsrc, unsigned lds_dst) { unsigned keep;
    asm volatile("s_mov_b32 %0, m0\n\ts_mov_b32 m0, %2\n\ts_nop 0\n\tglobal_load_lds_dwordx4 %1, off\n\ts_mov_b32 m0, %0" : "=&s"(keep) : "v"(gsrc), "s"(lds_dst) : "memory"); }
#define MLA_WAIT_BAR(N) asm volatile("s_waitcnt vmcnt(" #N ") lgkmcnt(0)\n\ts_barrier" ::: "memory")
__device__ __forceinline__ void mla_unit(const Frame& F, int b, int h, int qb, const bf16* QKV, const bf16* KR, bf16* Y) {
    int tid = F.tid; asm volatile("" : "+v"(tid));
    const int lane = tid & 63, wid = F.wave, r32 = lane & 31, hi = lane >> 5;
    const LAS unsigned char* lds = F.lds;
    const unsigned lds0 = (unsigned)(uintptr_t)F.lds;
    LAS float* wsf = (LAS float*)(F.lds + MLA_WS) + wid * 32;
    const size_t rb = (size_t)b * SEQ; const int q0 = qb * 256;
    const int qrow = q0 + 32 * wid + r32;
    const int NT = (q0 + 256) / 64;
    const int tmax = q0 / 64 + (wid >> 1);
    const bf16* ksrc = at(QKV + rb * NUP + 768 + h * 128 + wid * 8, (unsigned)(lane * NUP) * 2u);
    const bf16* rsrc = at(KR + rb * 32 + (wid & 3) * 8, (unsigned)(lane * 32) * 2u);
    const bf16* vsrc = at(QKV + rb * NUP + 768 + h * 128 + 64 + (wid >> 2) * 32, (unsigned)((16 * (wid & 3) + (lane >> 2)) * NUP + (lane & 3) * 8) * 2u);
    const unsigned kdst = lds0 + MLA_K0 + wid * 1024, rdst = lds0 + MLA_K0 + (8 + (wid & 3)) * 1024, vdst = lds0 + MLA_V0 + wid * 1024;
#define MLA_DMA(t, slot) do { glds16(ksrc + (size_t)(t) * 64 * NUP, (unsigned)__builtin_amdgcn_readfirstlane(kdst + (slot) * MLA_KSLOT)); \
        glds16(rsrc + (size_t)(t) * 64 * 32, (unsigned)__builtin_amdgcn_readfirstlane(rdst + (slot) * MLA_KSLOT)); \
        glds16(vsrc + (size_t)(t) * 64 * NUP, (unsigned)__builtin_amdgcn_readfirstlane(vdst + (slot) * MLA_VSLOT)); } while (0)
    MLA_DMA(0, 0); MLA_DMA(1, 1);
    bf16x8 qf[6];
#pragma unroll
    for (int s = 0; s < 6; ++s) qf[s] = *(const bf16x8*)at(QKV + (rb + q0 + 32 * wid) * NUP + h * 96, (unsigned)(r32 * NUP + 16 * s + 8 * hi) * 2u);
    float mrun = -1e30f, lrun = 0.f; f32x16 O[2]; O[0] = (f32x16){}; O[1] = (f32x16){};
    const int koff = hi * 1024 + r32 * 16;
    const int voff = (4 * hi + ((lane & 15) >> 2)) * 64 + (16 * ((lane >> 4) & 1) + 4 * (lane & 3)) * 2;
    int slot = 0;
    for (int t = 0; t < NT; ++t) {
        if (t + 1 < NT) MLA_WAIT_BAR(3); else MLA_WAIT_BAR(0);
        if (t + 2 < NT) { const int s2 = slot == 0 ? 2 : slot - 1; MLA_DMA(t + 2, s2); }
        if (t <= tmax) {
            const LAS unsigned char* kt = lds + MLA_K0 + slot * MLA_KSLOT + koff;
            f32x16 X0 = (f32x16){}, X1 = (f32x16){};
#pragma unroll
            for (int s = 0; s < 6; ++s) { const bf16x8 k0 = *(const LAS bf16x8*)(kt + s * 2048), k1 = *(const LAS bf16x8*)(kt + s * 2048 + 512); X0 = MFMA32(k0, qf[s], X0); X1 = MFMA32(k1, qf[s], X1); }
            if (64 * t + 63 > q0 + 32 * wid) {
#pragma unroll
                for (int r = 0; r < 16; ++r) { const int kk = 64 * t + crow(r, hi); if (kk > qrow) X0[r] = -INFINITY; if (kk + 32 > qrow) X1[r] = -INFINITY; }
            }
            float rm = X0[0];
#pragma unroll
            for (int r = 1; r < 16; ++r) rm = fmaxf(rm, X0[r]);
#pragma unroll
            for (int r = 0; r < 16; ++r) rm = fmaxf(rm, X1[r]);
            rm = fmaxf(rm, __shfl_xor(rm, 32));
            if (__any(rm > mrun + 8.0f)) {
                const float mnew = fmaxf(mrun, rm), alpha = __builtin_amdgcn_exp2f(mrun - mnew);
                mrun = mnew; lrun *= alpha;
                if (hi == 0) wsf[lane] = alpha;
                asm volatile("s_waitcnt lgkmcnt(0)" ::: "memory");
#pragma unroll
                for (int r = 0; r < 16; ++r) { const float a = wsf[crow(r, hi)]; O[0][r] *= a; O[1][r] *= a; }
                asm volatile("s_waitcnt lgkmcnt(0)" ::: "memory");
            }
            float ps = 0.f;
#pragma unroll
            for (int r = 0; r < 16; ++r) { X0[r] = __builtin_amdgcn_exp2f(X0[r] - mrun); X1[r] = __builtin_amdgcn_exp2f(X1[r] - mrun); ps += X0[r] + X1[r]; }
            lrun += ps;
            const bf16x8 pa0 = pack8(X0[0], X0[1], X0[2], X0[3], X0[4], X0[5], X0[6], X0[7]), pa1 = pack8(X0[8], X0[9], X0[10], X0[11], X0[12], X0[13], X0[14], X0[15]);
            const bf16x8 pa2 = pack8(X1[0], X1[1], X1[2], X1[3], X1[4], X1[5], X1[6], X1[7]), pa3 = pack8(X1[8], X1[9], X1[10], X1[11], X1[12], X1[13], X1[14], X1[15]);
            const LAS unsigned char* vl = lds + MLA_V0 + slot * MLA_VSLOT + voff;
#pragma unroll
            for (int dt = 0; dt < 2; ++dt) {
                const bf16x8 v0 = tr_frag(vl + (dt * 4 + 0) * 1024, vl + (dt * 4 + 0) * 1024 + 512), v1 = tr_frag(vl + (dt * 4 + 1) * 1024, vl + (dt * 4 + 1) * 1024 + 512);
                const bf16x8 v2 = tr_frag(vl + (dt * 4 + 2) * 1024, vl + (dt * 4 + 2) * 1024 + 512), v3 = tr_frag(vl + (dt * 4 + 3) * 1024, vl + (dt * 4 + 3) * 1024 + 512);
                O[dt] = MFMA32(pa0, v0, O[dt]); O[dt] = MFMA32(pa1, v1, O[dt]); O[dt] = MFMA32(pa2, v2, O[dt]); O[dt] = MFMA32(pa3, v3, O[dt]);
            }
        }
        slot = slot == 2 ? 0 : slot + 1;
    }
    lrun += __shfl_xor(lrun, 32);
    if (hi == 0) wsf[lane] = 1.0f / lrun;
    asm volatile("s_waitcnt lgkmcnt(0)" ::: "memory");
    LAS bf16* stg = (LAS bf16*)(F.lds + MLA_OST) + wid * 2048;
#pragma unroll
    for (int r = 0; r < 16; ++r) { const float a = wsf[crow(r, hi)]; const int orow = crow(r, hi);
        stg[orow * 64 + r32] = (bf16)(cvt_pk(O[0][r] * a, 0.f) & 0xffffu); stg[orow * 64 + 32 + r32] = (bf16)(cvt_pk(O[1][r] * a, 0.f) & 0xffffu); }
    asm volatile("s_waitcnt lgkmcnt(0)" ::: "memory");
    bf16* Yw = Y + (rb + q0 + 32 * wid) * D + h * 64;
#pragma unroll
    for (int i = 0; i < 4; ++i) { const int row = i * 8 + (lane >> 3), ch = lane & 7; const u32x4 v = *(const LAS u32x4*)(stg + row * 64 + ch * 8); *(u32x4*)at(Yw, (unsigned)(row * D + ch * 8) * 2u) = v; }
    asm volatile("s_waitcnt lgkmcnt(0)\n\ts_barrier" ::: "memory");
#undef MLA_DMA
}

constexpr int RT_VP = 320;
__device__ __forceinline__ void stage_tile128(LAS unsigned char* dst, const bf16* src, size_t ld, int tid) {
#pragma unroll
    for (int i = 0; i < 4; ++i) { const int p = tid + 512 * i, row = p >> 4, ch = p & 15; *(LAS u32x4*)(dst + row * RT_VP + ch * 16) = *(const u32x4*)at(src, (unsigned)(row * (int)ld + ch * 8) * 2u); }
}
__device__ __forceinline__ void ret_kv_unit(const Frame& F, int U, const bf16* RK, const bf16* RV, float* KVT) {
    int tid = F.tid; asm volatile("" : "+v"(tid));
    const int lane = tid & 63, wid = F.wave, hi = lane >> 5;
    const int bh = U >> 5, c = U & 31, b = bh >> 2, h = bh & 3;
    const size_t t0 = (size_t)b * SEQ + c * 128;
    LAS unsigned char* kt = F.lds; LAS unsigned char* vt = F.lds + 128 * RT_VP;
    stage_tile128(kt, RK + t0 * 512 + h * 128, 512, tid); stage_tile128(vt, RV + t0 * 512 + h * 128, 512, tid);
    __syncthreads();
    const int dvb = wid >> 1, dk0 = 2 * (wid & 1);
    f32x16 acc0 = (f32x16){}, acc1 = (f32x16){};
    const int lo = (8 * hi + ((lane & 15) >> 2)) * RT_VP + (16 * ((lane >> 4) & 1) + 4 * (lane & 3)) * 2;
#pragma unroll
    for (int s = 0; s < 8; ++s) {
        const bf16x8 af = tr_frag(vt + lo + 16 * s * RT_VP + dvb * 64, vt + lo + (16 * s + 4) * RT_VP + dvb * 64);
        const bf16x8 b0 = tr_frag(kt + lo + 16 * s * RT_VP + dk0 * 64, kt + lo + (16 * s + 4) * RT_VP + dk0 * 64);
        const bf16x8 b1 = tr_frag(kt + lo + 16 * s * RT_VP + (dk0 + 1) * 64, kt + lo + (16 * s + 4) * RT_VP + (dk0 + 1) * 64);
        acc0 = MFMA32(af, b0, acc0); acc1 = MFMA32(af, b1, acc1);
    }
    float* o = KVT + (size_t)U * 16384 + (size_t)(32 * dvb) * 128 + 32 * dk0;
#pragma unroll
    for (int r = 0; r < 16; ++r) { *at(o, (unsigned)(crow(r, hi) * 128 + (lane & 31)) * 4u) = acc0[r]; *at(o, (unsigned)(crow(r, hi) * 128 + 32 + (lane & 31)) * 4u) = acc1[r]; }
    __syncthreads();
}
__device__ __forceinline__ void ret_scan(const Frame& F, float* KVT) {
    const int gt = F.vcu * 512 + F.tid, NT = F.G * 512;
    for (int i = gt; i < 16 * 16384; i += NT) {
        const int bh = i >> 14, e = i & 16383, h = bh & 3;
        const float lg = __builtin_amdgcn_logf(1.0f - __builtin_amdgcn_exp2f(-5.0f - (float)h));
        const float dec = __builtin_amdgcn_exp2f(128.0f * lg);
        const unsigned po = (unsigned)(bh * 32 * 16384 + e) * 4u; float st = 0.f;
#pragma unroll 8
        for (int c = 0; c < 32; ++c) { float* p = at(KVT, po + (unsigned)c * 65536u); const float v = *p; *p = st; st = dec * st + v; }
    }
}
__device__ __forceinline__ void ret_out_pair(const Frame& F, int pair, const bf16* RQ, const bf16* RK, const bf16* RV, const bf16* RG, const float* KVT, bf16* Y) {
    int tid = F.tid; asm volatile("" : "+v"(tid));
    const int lane = tid & 63, wid = F.wave, r32 = lane & 31, hi = lane >> 5;
    const int u = wid >> 2, ib = wid & 3, U = 2 * pair + u;
    const int bh = U >> 5, c = U & 31, b = bh >> 2, h = bh & 3;
    const size_t t0 = (size_t)b * SEQ + c * 128;
    {
        const int U0 = 2 * pair, bh0 = U0 >> 5, c0 = U0 & 31; const size_t s0 = (size_t)(bh0 >> 2) * SEQ + c0 * 128;
        stage_tile128(F.lds, RV + s0 * 512 + (bh0 & 3) * 128, 512, tid);
        const int U1 = U0 + 1, bh1 = U1 >> 5, c1 = U1 & 31; const size_t s1 = (size_t)(bh1 >> 2) * SEQ + c1 * 128;
        stage_tile128(F.lds + 128 * RT_VP, RV + s1 * 512 + (bh1 & 3) * 128, 512, tid);
    }
    __syncthreads();
    const LAS unsigned char* vt = F.lds + u * 128 * RT_VP;
    const float lg = __builtin_amdgcn_logf(1.0f - __builtin_amdgcn_exp2f(-5.0f - (float)h));
    bf16x8 qf[8];
#pragma unroll
    for (int s = 0; s < 8; ++s) qf[s] = *(const bf16x8*)at(RQ + (t0 + 32 * ib) * 512 + h * 128, (unsigned)(r32 * 512 + 16 * s + 8 * hi) * 2u);
    f32x16 acc[4]; acc[0] = (f32x16){}; acc[1] = (f32x16){}; acc[2] = (f32x16){}; acc[3] = (f32x16){};
    if (c > 0) {
        const float* pv = at(KVT + (size_t)U * 16384, (unsigned)(r32 * 128 + 8 * hi) * 4u);
#pragma unroll
        for (int s = 0; s < 8; ++s)
#pragma unroll
            for (int dt = 0; dt < 4; ++dt) { const f32x4 a = *(const f32x4*)(pv + (size_t)dt * 32 * 128 + 16 * s), bq = *(const f32x4*)(pv + (size_t)dt * 32 * 128 + 16 * s + 4);
                acc[dt] = MFMA32(qf[s], pack8(a[0], a[1], a[2], a[3], bq[0], bq[1], bq[2], bq[3]), acc[dt]); }
#pragma unroll
        for (int r = 0; r < 16; ++r) { const float sc = __builtin_amdgcn_exp2f((float)(32 * ib + crow(r, hi) + 1) * lg);
#pragma unroll
            for (int dt = 0; dt < 4; ++dt) acc[dt][r] *= sc; }
    }
    const float colsc = __builtin_amdgcn_exp2f((float)(32 * ib + r32 - 127) * lg);
    const int vlo = (4 * hi + ((lane & 15) >> 2)) * RT_VP + (16 * ((lane >> 4) & 1) + 4 * (lane & 3)) * 2;
#pragma unroll 1
    for (int jb = 0; jb <= ib; ++jb) {
        f32x16 X = (f32x16){};
        const bf16* kp = at(RK + (t0 + 32 * jb) * 512 + h * 128, (unsigned)(r32 * 512 + 8 * hi) * 2u);
#pragma unroll
        for (int s = 0; s < 8; ++s) X = MFMA32(*(const bf16x8*)(kp + 16 * s), qf[s], X);
#pragma unroll
        for (int r = 0; r < 16; ++r) { X[r] *= colsc; if (jb == ib && crow(r, hi) > r32) X[r] = 0.f; }
        const bf16x8 pa0 = pack8(X[0], X[1], X[2], X[3], X[4], X[5], X[6], X[7]), pa1 = pack8(X[8], X[9], X[10], X[11], X[12], X[13], X[14], X[15]);
        const LAS unsigned char* vb = vt + vlo + 32 * jb * RT_VP;
#pragma unroll
        for (int dt = 0; dt < 4; ++dt) {
            const bf16x8 v0 = tr_frag(vb + dt * 64, vb + 8 * RT_VP + dt * 64), v1 = tr_frag(vb + 16 * RT_VP + dt * 64, vb + 24 * RT_VP + dt * 64);
            acc[dt] = MFMA32(pa0, v0, acc[dt]); acc[dt] = MFMA32(pa1, v1, acc[dt]);
        }
    }
#pragma unroll
    for (int r = 0; r < 16; ++r) {
        float s1 = (acc[0][r] + acc[1][r]) + (acc[2][r] + acc[3][r]);
        float s2 = (acc[0][r] * acc[0][r] + acc[1][r] * acc[1][r]) + (acc[2][r] * acc[2][r] + acc[3][r] * acc[3][r]);
#pragma unroll
        for (int o = 1; o < 32; o <<= 1) { s1 += __shfl_xor(s1, o); s2 += __shfl_xor(s2, o); }
        const float mean = s1 * (1.0f / 128.0f), var = fmaxf(s2 * (1.0f / 128.0f) - mean * mean, 0.f), rstd = 1.0f / sqrtf(var + EPS);
        const int rl = crow(r, hi);
#pragma unroll
        for (int dt = 0; dt < 4; ++dt) { const float g = bf2f(*at(RG + (t0 + 32 * ib) * 512 + h * 128, (unsigned)(rl * 512 + 32 * dt + r32) * 2u));
            const unsigned w = cvt_pk((acc[dt][r] - mean) * rstd * g, 0.f); *at(Y + (t0 + 32 * ib) * D + 512 + h * 128, (unsigned)(rl * D + 32 * dt + r32) * 2u) = (bf16)(w & 0xffffu); }
    }
    __syncthreads();
}

constexpr int N_PHASES = 12;
struct Args { const void* in[21]; float* out; unsigned char* ws; int ph_lo, ph_hi, flags, li; };
__global__ void __launch_bounds__(NWAVES * 64, 2) hymba_fwd(Args args) {
    extern __shared__ __attribute__((aligned(16))) unsigned char lds_raw[];
    Frame F;
    F.lds = (LAS unsigned char*)lds_raw;
    F.tid = threadIdx.x; F.lane = F.tid & 63; F.wave = __builtin_amdgcn_readfirstlane(F.tid >> 6);
    F.G = gridDim.x; { const int bx = blockIdx.x; F.vcu = (F.G % 8 == 0) ? (bx % 8) * (F.G / 8) + bx / 8 : bx; }
    Ptrs P;
    P.x = (const float*)args.in[0]; P.mem = (const float*)args.in[1]; P.pos = (const int*)args.in[2]; P.g_mix = (const float*)args.in[3]; P.w_in = (const float*)args.in[4];
    P.g_q_lat = (const float*)args.in[5]; P.w_uq = (const float*)args.in[6]; P.g_kv_lat = (const float*)args.in[7]; P.w_ukv = (const float*)args.in[8]; P.w_out = (const float*)args.in[9];
    P.g_xattn = (const float*)args.in[10]; P.g_mem = (const float*)args.in[11]; P.w_xq = (const float*)args.in[12]; P.w_xkv = (const float*)args.in[13]; P.w_xo = (const float*)args.in[14];
    P.g_ffn = (const float*)args.in[15]; P.w_ffn_in = (const float*)args.in[16]; P.conv_w = (const float*)args.in[17]; P.conv_b = (const float*)args.in[18]; P.w_ffn_out = (const float*)args.in[19];
    P.g_final = (const float*)args.in[20]; P.out = args.out; P.ws = args.ws;
    unsigned char* ws = args.ws;
    gu32* ctl = (gu32*)(ws + WS_CTL);
    volatile LAS unsigned* MISC = (volatile LAS unsigned*)(F.lds + MISC_OFF);
    for (int u = F.tid; u < (LDS_BYTES - LDSCTL_OFF) / 4; u += NWAVES * 64) ((LAS unsigned*)(F.lds + LDSCTL_OFF))[u] = 0u;
    __syncthreads();
    XcdBarrier bar; bar.bar = (unsigned*)(ctl + CW_BAR) + args.li * XCD_BAR_WORDS; bar.x = 0; bar.st = nullptr;
    if (MK_N_LAUNCHES == 1) bar = xcd_barrier_post((unsigned*)(ctl + CW_BAR) + args.li * XCD_BAR_WORDS, MISC + 8);
    const int lo = args.ph_lo, hi_ph = args.ph_hi;
#ifndef PH_MASK
#define PH_MASK 0xFFF
#endif
#define IN(k) ((((PH_MASK) >> (k)) & 1) && lo <= (k) && (k) < hi_ph)
#define SEAM(k) do { if (IN(k) && IN((k) + 1)) xcd_barrier(bar); } while (0)

    bf16* Win = (bf16*)(ws + WS_WIN); bf16* Wup = (bf16*)(ws + WS_WUP); bf16* Wout = (bf16*)(ws + WS_WOUT); bf16* Wxq = (bf16*)(ws + WS_WXQ); bf16* Wxkv = (bf16*)(ws + WS_WXKV);
    bf16* Wxo = (bf16*)(ws + WS_WXO); bf16* Wffi = (bf16*)(ws + WS_WFFI); bf16* Wffo = (bf16*)(ws + WS_WFFO);
    float* CS = (float*)(ws + WS_CS); float* SSQL = (float*)(ws + WS_SSQL); float* SSQ1 = (float*)(ws + WS_SSQ1); float* SSQ2 = (float*)(ws + WS_SSQ2);
    bf16* MEMN = (bf16*)(ws + WS_MEMN); bf16* KH = (bf16*)(ws + WS_KH); bf16* VTH = (bf16*)(ws + WS_VTH); bf16* PX = (bf16*)(ws + WS_PX); float* SUMP = (float*)(ws + WS_SUMP);
    bf16* XN = (bf16*)(ws + WS_A); bf16* Y = (bf16*)(ws + WS_A); bf16* XB2 = (bf16*)(ws + WS_A);
    bf16* LAT = (bf16*)(ws + WS_LAT); bf16* KR = (bf16*)(ws + WS_KR); bf16* RQ = (bf16*)(ws + WS_RQ); bf16* RK = (bf16*)(ws + WS_RK); bf16* RV = (bf16*)(ws + WS_RV); bf16* RG = (bf16*)(ws + WS_RG);
    bf16* QKV = (bf16*)(ws + WS_C); float* KVT = (float*)(ws + WS_KVT);
    bf16* XB1 = (bf16*)(ws + WS_XB1); bf16* HB = (bf16*)(ws + WS_H); bf16* QX = (bf16*)(ws + WS_QX); bf16* OX = (bf16*)(ws + WS_OX);
    const int bx = (int)blockIdx.x;

    if (IN(0)) { p0_prologue(F, P); }
    SEAM(0);
    if (IN(1)) {
        pg8::Gemm g{XN, Win, D, 64, 0, 0}; pg8::StaticOrder S; S.init(M / 256, NPROJ / 256, F.G, bx);
        EpiProj E{LAT, KR, RQ, RK, RV, RG, SSQL, CS};
        pg8::gemm_phase(F.lds, g, S, E);
    }
    SEAM(1);
    if (IN(2)) {
        { pg8::Gemm g{LAT, Wup, NLAT, 64, 0, 0}; pg8::StaticOrder S; S.init(M / 256, NUP / 256, F.G, bx); EpiUp E{QKV, SSQL, CS}; pg8::gemm_phase(F.lds, g, S, E); }
        { pg8::Gemm g{MEMN, Wxkv, D, 64, 0, 0}; pg8::StaticOrder S; S.init(4, 4, F.G, (bx + 64) % F.G); EpiTile E{KH, 4, 1, nullptr, 1.0f}; pg8::gemm_phase(F.lds, g, S, E); }
        { pg8::Gemm g{Wxkv + (size_t)1024 * D, MEMN, D, 64, 0, 0}; pg8::StaticOrder S; S.init(4, 4, F.G, (bx + 48) % F.G); EpiTile E{VTH, 1, 4, nullptr, 1.0f}; pg8::gemm_phase(F.lds, g, S, E); }
        __syncthreads();
        for (int U = F.vcu; U < 512; U += F.G) ret_kv_unit(F, U, RK, RV, KVT);
    }
    SEAM(2);
    if (IN(3)) {
        if (!(args.flags & 1)) ret_scan(F, KVT);
        for (int v = F.vcu; v < 256; v += F.G) { const int bh = v >> 3, s = v & 7;
            mla_unit(F, bh >> 3, bh & 7, 15 - s, QKV, KR, Y); mla_unit(F, bh >> 3, bh & 7, s, QKV, KR, Y); }
    }
    SEAM(3);
    if (IN(4)) { for (int p = F.vcu; p < 256; p += F.G) ret_out_pair(F, p, RQ, RK, RV, RG, KVT, Y); }
    SEAM(4);
    if (IN(5)) { pg8::Gemm g{Y, Wout, D, 64, 0, 0}; pg8::StaticOrder S; S.init(M / 256, 4, F.G, bx); EpiRes<false> E{P.x, nullptr, XB1, SSQ1}; pg8::gemm_phase(F.lds, g, S, E); }
    SEAM(5);
    if (IN(6)) {
        { pg8::Gemm g{XB1, Wxq, D, 64, 0, 0}; pg8::StaticOrder S; S.init(M / 256, 4, F.G, bx); EpiTile E{QX, 1, M / 256, SSQ1, C2_X}; pg8::gemm_phase(F.lds, g, S, E); }
        { pg8::Gemm g{QX, KH, 256, 64, M / 256, 4}; pg8::StaticOrder S; S.init(M / 256, 4, F.G, bx); EpiSoftmax E{PX, SUMP}; pg8::gemm_phase(F.lds, g, S, E); }
        { pg8::Gemm g{PX, VTH, 256, 64, M / 256, 4}; pg8::StaticOrder S; S.init(M / 256, 4, F.G, bx); EpiPV E{OX, SUMP}; pg8::gemm_phase(F.lds, g, S, E); }
    }
    SEAM(6);
    if (IN(8)) { pg8::Gemm g{OX, Wxo, D, 64, 0, 0}; pg8::StaticOrder S; S.init(M / 256, 4, F.G, bx); EpiRes<true> E{XB1, nullptr, XB2, SSQ2}; pg8::gemm_phase(F.lds, g, S, E); }
    SEAM(8);
    if (IN(9)) { pg8::Gemm g{XB2 - 2 * D, Wffi, D, FF_BLK, 0, 0}; pg8::StaticOrder S; S.init(FF_NM, NFF / 256, F.G, bx); EpiFfn E{HB, SSQ2, P.conv_w, P.conv_b}; pg8::gemm_phase(F.lds, g, S, E); }
    SEAM(9);
    if (IN(10)) { pg8::Gemm g{HB, Wffo, DFF, 64, 0, 0}; pg8::StaticOrder S; S.init(M / 256, 4, F.G, bx); EpiRes<true> E{XB2, P.out, nullptr, nullptr}; pg8::gemm_phase(F.lds, g, S, E); }
    SEAM(10);
    if (IN(11)) {
        const int gw = F.vcu * NWAVES + F.wave, NGW = F.G * NWAVES, lane = F.lane;
        for (int m = gw; m < M; m += NGW) {
            f32x4* xr = (f32x4*)(P.out + (size_t)m * D) + lane; f32x4 v[4]; float s = 0.f;
#pragma unroll
            for (int j = 0; j < 4; ++j) { v[j] = xr[64 * j]; s += (v[j][0] * v[j][0] + v[j][1] * v[j][1]) + (v[j][2] * v[j][2] + v[j][3] * v[j][3]); }
            const float inv = 1.0f / sqrtf(wave_sum(s) * (1.0f / D) + EPS);
#pragma unroll
            for (int j = 0; j < 4; ++j) xr[64 * j] = v[j] * inv * ((const f32x4*)P.g_final)[lane + 64 * j];
        }
    }
#undef IN
#undef SEAM
}

extern "C" void kernel_launch(void* const* d_in, const int* in_sizes, int n_in, void* d_out, int out_size, void* d_ws, size_t ws_size, hipStream_t stream) {
    static int grid = 0;
    if (grid == 0) {
        int dev = 0, cus = 0;
        if (n_in != 21 || out_size != M * D || ws_size < WS_END) { fprintf(stderr, "kernel_launch: unexpected problem (n_in %d, out %d, ws %zu); nothing launched\n", n_in, out_size, ws_size); grid = -1; return; }
        if (hipGetDevice(&dev) != hipSuccess || hipDeviceGetAttribute(&cus, hipDeviceAttributeMultiprocessorCount, dev) != hipSuccess) { grid = -1; return; }
        if (hipFuncSetAttribute((const void*)hymba_fwd, hipFuncAttributeMaxDynamicSharedMemorySize, LDS_BYTES) != hipSuccess) { fprintf(stderr, "kernel_launch: hipFuncSetAttribute failed\n"); grid = -1; return; }
        int per_cu = 0;
        if (hipOccupancyMaxActiveBlocksPerMultiprocessor(&per_cu, (const void*)hymba_fwd, NWAVES * 64, LDS_BYTES) != hipSuccess || per_cu < 1) fprintf(stderr, "kernel_launch: occupancy query says %d blocks per CU\n", per_cu);
        (void)hipGetLastError();
        grid = cus;
    }
    if (grid < 0) return;
    if (hipMemsetAsync((char*)d_ws + WS_CTL, 0, CTL_ZERO_BYTES, stream) != hipSuccess) return;
    Args a{};
    for (int i = 0; i < 21; ++i) a.in[i] = d_in[i];
    a.out = (float*)d_out; a.ws = (unsigned char*)d_ws;
#ifdef PROBE_PHASE
    a.ph_lo = 0; a.ph_hi = PROBE_PHASE + 1; hipLaunchKernelGGL(hymba_fwd, dim3(grid), dim3(NWAVES * 64), LDS_BYTES, stream, a);
    a.ph_lo = PROBE_PHASE; a.ph_hi = PROBE_PHASE + 1; a.flags = 1; a.li = 1; hipLaunchKernelGGL(hymba_fwd, dim3(grid), dim3(NWAVES * 64), LDS_BYTES, stream, a);
    a.ph_lo = PROBE_PHASE + 1; a.ph_hi = N_PHASES; a.flags = 0; a.li = 2; hipLaunchKernelGGL(hymba_fwd, dim3(grid), dim3(NWAVES * 64), LDS_BYTES, stream, a);
#else
    if (MK_N_LAUNCHES == 1) { a.ph_lo = 0; a.ph_hi = N_PHASES; hipLaunchKernelGGL(hymba_fwd, dim3(grid), dim3(NWAVES * 64), LDS_BYTES, stream, a); }
#endif
#ifndef PROBE_PHASE
    else for (int p = 0; p < N_PHASES; ++p) { a.ph_lo = p; a.ph_hi = p + 1; hipLaunchKernelGGL(hymba_fwd, dim3(grid), dim3(NWAVES * 64), LDS_BYTES, stream, a); }
#endif
}
```
